# Optimizing an MI355X kernel written in HIP

```python
import math
import jax, jax.numpy as jnp
from jax import lax
import numpy as np

D_MODEL = 2048
BATCH = 4
SEQ = 4096
DEPTH = 2

GRID_W = 64
CTX_LEN = 256
CONV_DIM = 1024
CONV_K = 3
ATT_HEADS = 8
ATT_KV_HEADS = 2
HEAD_DIM = 128
MLA_HEADS = 16
Q_LORA = 512
KV_LORA = 512
QK_NOPE = 128
QK_ROPE = 64
V_DIM = 128
N_EXPERTS = 64
TOP_K = 6
N_GROUPS = 8
TOPK_GROUPS = 4
EXPERT_FF = 512
SHARED_FF = 512
ROUTED_SCALE = 2.5
MOE_BLOCK = 256
Q_BLOCK = 128
ROPE_THETA = 10000.0
LN_EPS = 1e-5
RMS_EPS = 1e-6
DN_ALPHA = (2 * DEPTH) ** 0.25
DN_BETA = (8 * DEPTH) ** -0.25

kernel_name = 'hybrid_conv_gqa_mla_moe_diffusion_trunk'


def rms_norm(x, g):
    xf = x.astype(jnp.float32)
    y = xf * lax.rsqrt(jnp.mean(xf * xf, axis=-1, keepdims=True) + RMS_EPS)
    return (y * g.astype(jnp.float32)).astype(x.dtype)


def layer_norm(x, g, b):
    xf = x.astype(jnp.float32)
    mu = jnp.mean(xf, axis=-1, keepdims=True)
    xc = xf - mu
    var = jnp.mean(xc * xc, axis=-1, keepdims=True)
    y = xc * lax.rsqrt(var + LN_EPS) * g.astype(jnp.float32) + b.astype(jnp.float32)
    return y.astype(x.dtype)


def axial_rope(n_tok, rot_dim):
    rows = n_tok // GRID_W
    n_freq = rot_dim // 4
    inv = ROPE_THETA ** (-jnp.arange(n_freq, dtype=jnp.float32) / n_freq)
    row = jnp.repeat(jnp.arange(rows, dtype=jnp.float32), GRID_W)
    col = jnp.tile(jnp.arange(GRID_W, dtype=jnp.float32), rows)
    ang = jnp.concatenate([row[:, None] * inv, col[:, None] * inv], axis=-1)
    return jnp.cos(ang), jnp.sin(ang)


def apply_rope(x, cos, sin):
    xf = x.astype(jnp.float32)
    x1, x2 = jnp.split(xf, 2, axis=-1)
    c = cos[:, None, :]
    s = sin[:, None, :]
    return jnp.concatenate([x1 * c - x2 * s, x2 * c + x1 * s], axis=-1).astype(x.dtype)


def attend(q, k, v, scale):
    s = jnp.einsum('bqhgd,bkhd->bhgqk', q, k, preferred_element_type=jnp.float32) * scale
    p = jax.nn.softmax(s, axis=-1).astype(v.dtype)
    o = jnp.einsum('bhgqk,bkhd->bqhgd', p, v)
    return o.reshape(o.shape[0], o.shape[1], -1, o.shape[-1])


def attend_blocked(q, k, v, scale):
    b, s = q.shape[0], q.shape[1]
    nb = s // Q_BLOCK
    qb = jnp.moveaxis(q.reshape(b, nb, Q_BLOCK, *q.shape[2:]), 1, 0)
    ob = lax.map(lambda qq: attend(qq, k, v, scale), qb)
    return jnp.moveaxis(ob, 0, 1).reshape(b, s, ob.shape[3], ob.shape[4])


def short_conv(x, w):
    return lax.conv_general_dilated(
        x, w[:, None, :].astype(x.dtype), window_strides=(1,),
        padding=((CONV_K // 2, CONV_K // 2),),
        dimension_numbers=('NWC', 'WIO', 'NWC'),
        feature_group_count=x.shape[-1])


def conv_attn_mixer(u_lat, u_ctx, w_in, conv_w, q_gain, k_gain, w_out, ctx_out):
    d_q = ATT_HEADS * HEAD_DIM
    d_kv = ATT_KV_HEADS * HEAD_DIM
    kv_lo = 3 * CONV_DIM + d_q
    cuts = [CONV_DIM, 2 * CONV_DIM, 3 * CONV_DIM, kv_lo, kv_lo + d_kv]
    grp = ATT_HEADS // ATT_KV_HEADS
    scale = 1.0 / math.sqrt(HEAD_DIM)

    def heads(t, n, gain):
        return rms_norm(t.reshape(t.shape[0], t.shape[1], n, HEAD_DIM), gain)

    gb, gc, hv, q, k, v = jnp.split(u_lat @ w_in, cuts, axis=-1)
    cos, sin = axial_rope(u_lat.shape[1], HEAD_DIM)
    q = apply_rope(heads(q, ATT_HEADS, q_gain), cos, sin)
    k = apply_rope(heads(k, ATT_KV_HEADS, k_gain), cos, sin)
    v = v.reshape(v.shape[0], v.shape[1], ATT_KV_HEADS, HEAD_DIM)

    if ctx_out:
        gb_c, gc_c, hv_c, q_c, k_c, v_c = jnp.split(u_ctx @ w_in, cuts, axis=-1)
    else:
        k_c, v_c = jnp.split(u_ctx @ w_in[:, kv_lo:], [d_kv], axis=-1)
    k_c = heads(k_c, ATT_KV_HEADS, k_gain)
    v_c = v_c.reshape(v_c.shape[0], v_c.shape[1], ATT_KV_HEADS, HEAD_DIM)

    k_all = jnp.concatenate([k_c, k], axis=1)
    v_all = jnp.concatenate([v_c, v], axis=1)
    q5 = q.reshape(q.shape[0], q.shape[1], ATT_KV_HEADS, grp, HEAD_DIM)
    att = attend_blocked(q5, k_all, v_all, scale)
    att = att.reshape(att.shape[0], att.shape[1], d_q)
    conv = gb * short_conv(gc * hv, conv_w)
    y_lat = jnp.concatenate([conv, att], axis=-1) @ w_out

    y_ctx = None
    if ctx_out:
        q_c = heads(q_c, ATT_HEADS, q_gain).reshape(q_c.shape[0], q_c.shape[1], ATT_KV_HEADS, grp, HEAD_DIM)
        att_c = attend(q_c, k_c, v_c, scale).reshape(q_c.shape[0], q_c.shape[1], d_q)
        conv_c = gb_c * short_conv(gc_c * hv_c, conv_w)
        y_ctx = jnp.concatenate([conv_c, att_c], axis=-1) @ w_out
    return y_lat, y_ctx


def mla_mixer(u_lat, u_ctx, w_down, q_gain, kv_gain, w_uq, w_ukv, w_out, ctx_out):
    scale = 1.0 / math.sqrt(QK_NOPE + QK_ROPE)

    def queries(cq, rope):
        qq = rms_norm(cq, q_gain) @ w_uq
        qq = qq.reshape(cq.shape[0], cq.shape[1], MLA_HEADS, QK_NOPE + QK_ROPE)
        q_nope, q_rope = jnp.split(qq, [QK_NOPE], axis=-1)
        if rope is not None:
            q_rope = apply_rope(q_rope, *rope)
        return jnp.concatenate([q_nope, q_rope], axis=-1)[:, :, :, None, :]

    def keys_values(ckv, kr, rope):
        kv = rms_norm(ckv, kv_gain) @ w_ukv
        kv = kv.reshape(ckv.shape[0], ckv.shape[1], MLA_HEADS, QK_NOPE + V_DIM)
        k_nope, vv = jnp.split(kv, [QK_NOPE], axis=-1)
        kr = kr[:, :, None, :]
        if rope is not None:
            kr = apply_rope(kr, *rope)
        kk = jnp.concatenate([k_nope, jnp.broadcast_to(kr, k_nope.shape[:-1] + (QK_ROPE,))], axis=-1)
        return kk, vv

    rope = axial_rope(u_lat.shape[1], QK_ROPE)
    cq, ckv, kr = jnp.split(u_lat @ w_down, [Q_LORA, Q_LORA + KV_LORA], axis=-1)
    q = queries(cq, rope)
    k, v = keys_values(ckv, kr, rope)

    if ctx_out:
        cq_c, ckv_c, kr_c = jnp.split(u_ctx @ w_down, [Q_LORA, Q_LORA + KV_LORA], axis=-1)
    else:
        ckv_c, kr_c = jnp.split(u_ctx @ w_down[:, Q_LORA:], [KV_LORA], axis=-1)
    k_c, v_c = keys_values(ckv_c, kr_c, None)

    k_all = jnp.concatenate([k_c, k], axis=1)
    v_all = jnp.concatenate([v_c, v], axis=1)
    att = attend_blocked(q, k_all, v_all, scale)
    y_lat = att.reshape(att.shape[0], att.shape[1], MLA_HEADS * V_DIM) @ w_out

    y_ctx = None
    if ctx_out:
        att_c = attend(queries(cq_c, None), k_c, v_c, scale)
        y_ctx = att_c.reshape(att_c.shape[0], att_c.shape[1], MLA_HEADS * V_DIM) @ w_out
    return y_lat, y_ctx


def moe_ffn(t, router_w, router_b, w_gate, w_up, w_down, s_gate, s_up, s_down):
    n_tok, d = t.shape
    logits = jnp.einsum('td,de->te', t, router_w, preferred_element_type=jnp.float32)
    scores = jax.nn.sigmoid(logits)
    sel = scores + router_b.astype(jnp.float32)
    grp_score = lax.top_k(sel.reshape(n_tok, N_GROUPS, N_EXPERTS // N_GROUPS), 2)[0].sum(-1)
    _, gidx = lax.top_k(grp_score, TOPK_GROUPS)
    gmask = jnp.any(gidx[:, :, None] == jnp.arange(N_GROUPS)[None, None, :], axis=1)
    sel = jnp.where(jnp.repeat(gmask, N_EXPERTS // N_GROUPS, axis=1), sel, -jnp.inf)
    _, eidx = lax.top_k(sel, TOP_K)
    gw = jnp.take_along_axis(scores, eidx, axis=1)
    gw = gw / jnp.sum(gw, axis=-1, keepdims=True) * ROUTED_SCALE

    n_asg = n_tok * TOP_K
    flat_e = eidx.reshape(-1)
    flat_t = jnp.repeat(jnp.arange(n_tok, dtype=jnp.int32), TOP_K)
    flat_w = gw.reshape(-1)
    order = jnp.argsort(flat_e)
    se = flat_e[order]
    counts = jnp.bincount(flat_e, length=N_EXPERTS)
    padded = (counts + MOE_BLOCK - 1) // MOE_BLOCK * MOE_BLOCK
    pend = jnp.cumsum(padded)
    pstart = pend - padded
    ustart = jnp.cumsum(counts) - counts
    dest = pstart[se] + jnp.arange(n_asg, dtype=jnp.int32) - ustart[se]
    n_blocks = (n_asg + N_EXPERTS * (MOE_BLOCK - 1)) // MOE_BLOCK + 1
    cap = n_blocks * MOE_BLOCK
    slot_tok = jnp.full((cap,), n_tok, jnp.int32).at[dest].set(flat_t[order])
    slot_w = jnp.zeros((cap,), jnp.float32).at[dest].set(flat_w[order])
    block_start = jnp.arange(n_blocks, dtype=pend.dtype) * MOE_BLOCK
    block_e = jnp.minimum(jnp.searchsorted(pend, block_start, side='right'), N_EXPERTS - 1)

    t_pad = jnp.concatenate([t, jnp.zeros((1, d), t.dtype)], axis=0)

    def expert_block(args):
        tok, e = args
        xb = t_pad[tok]
        hb = jax.nn.silu(xb @ w_gate[e]) * (xb @ w_up[e])
        return hb @ w_down[e]

    yb = lax.map(expert_block, (slot_tok.reshape(n_blocks, MOE_BLOCK), block_e))
    yb = yb.reshape(cap, d) * slot_w[:, None].astype(yb.dtype)
    routed = jax.ops.segment_sum(yb, slot_tok, num_segments=n_tok + 1)[:n_tok]
    shared = (jax.nn.silu(t @ s_gate) * (t @ s_up)) @ s_down
    return routed + shared


def setup_inputs(seed: int = 0) -> dict:
    key = jax.random.key(seed)
    ks = iter(jax.random.split(key, 32))
    f32 = jnp.float32

    def nrm(shape, scale):
        return jax.random.normal(next(ks), shape, f32) * scale

    d = D_MODEL
    n_even = (DEPTH + 1) // 2
    n_odd = DEPTH // 2
    a_in = 3 * CONV_DIM + (ATT_HEADS + 2 * ATT_KV_HEADS) * HEAD_DIM
    a_mix = CONV_DIM + ATT_HEADS * HEAD_DIM
    m_mix = MLA_HEADS * V_DIM
    return {
        'x': nrm((BATCH, SEQ, d), 1.0),
        'c': nrm((BATCH, d), 1.0),
        'ctx': nrm((BATCH, CTX_LEN, d), 1.0),
        'c_ctx': nrm((d,), 1.0),
        'w_ada': nrm((DEPTH, d, 6 * d), 0.5 * d ** -0.5),
        'b_ada': nrm((DEPTH, 6 * d), 0.02),
        'ln_g': 1.0 + nrm((DEPTH, 2, d), 0.02),
        'ln_b': nrm((DEPTH, 2, d), 0.02),
        'a_w_in': nrm((n_even, d, a_in), d ** -0.5),
        'a_conv_w': nrm((n_even, CONV_K, CONV_DIM), CONV_K ** -0.5),
        'a_q_gain': 1.0 + nrm((n_even, HEAD_DIM), 0.02),
        'a_k_gain': 1.0 + nrm((n_even, HEAD_DIM), 0.02),
        'a_w_out': nrm((n_even, a_mix, d), DN_BETA * a_mix ** -0.5),
        'm_w_down': nrm((n_odd, d, Q_LORA + KV_LORA + QK_ROPE), d ** -0.5),
        'm_q_gain': 1.0 + nrm((n_odd, Q_LORA), 0.02),
        'm_kv_gain': 1.0 + nrm((n_odd, KV_LORA), 0.02),
        'm_w_uq': nrm((n_odd, Q_LORA, MLA_HEADS * (QK_NOPE + QK_ROPE)), Q_LORA ** -0.5),
        'm_w_ukv': nrm((n_odd, KV_LORA, MLA_HEADS * (QK_NOPE + V_DIM)), KV_LORA ** -0.5),
        'm_w_out': nrm((n_odd, m_mix, d), DN_BETA * m_mix ** -0.5),
        'router_w': nrm((DEPTH, d, N_EXPERTS), d ** -0.5),
        'router_b': nrm((DEPTH, N_EXPERTS), 0.01),
        'e_w_gate': nrm((DEPTH, N_EXPERTS, d, EXPERT_FF), d ** -0.5),
        'e_w_up': nrm((DEPTH, N_EXPERTS, d, EXPERT_FF), d ** -0.5),
        'e_w_down': nrm((DEPTH, N_EXPERTS, EXPERT_FF, d), DN_BETA * EXPERT_FF ** -0.5),
        's_w_gate': nrm((DEPTH, d, SHARED_FF), d ** -0.5),
        's_w_up': nrm((DEPTH, d, SHARED_FF), d ** -0.5),
        's_w_down': nrm((DEPTH, SHARED_FF, d), DN_BETA * SHARED_FF ** -0.5),
    }


def reference(x, c, ctx, c_ctx, w_ada, b_ada, ln_g, ln_b, a_w_in, a_conv_w, a_q_gain, a_k_gain, a_w_out,
              m_w_down, m_q_gain, m_kv_gain, m_w_uq, m_w_ukv, m_w_out, router_w, router_b,
              e_w_gate, e_w_up, e_w_down, s_w_gate, s_w_up, s_w_down):
    h = ctx
    n_lat = x.shape[0] * x.shape[1]
    silu_c = jax.nn.silu(c)
    silu_cc = jax.nn.silu(c_ctx)
    for i in range(DEPTH):
        last = i == DEPTH - 1
        j = i // 2
        mod = (silu_c @ w_ada[i] + b_ada[i])[:, None, :]
        mod_c = silu_cc @ w_ada[i] + b_ada[i]
        sh_m, sc_m, g_m, sh_f, sc_f, g_f = jnp.split(mod, 6, axis=-1)
        shc_m, scc_m, gc_m, shc_f, scc_f, gc_f = jnp.split(mod_c, 6, axis=-1)

        u = x * (1 + sc_m) + sh_m
        uc = h * (1 + scc_m) + shc_m
        if i % 2 == 0:
            y, yc = conv_attn_mixer(u, uc, a_w_in[j], a_conv_w[j], a_q_gain[j], a_k_gain[j], a_w_out[j], not last)
        else:
            y, yc = mla_mixer(u, uc, m_w_down[j], m_q_gain[j], m_kv_gain[j], m_w_uq[j], m_w_ukv[j], m_w_out[j], not last)
        x = layer_norm(DN_ALPHA * x + g_m * y, ln_g[i, 0], ln_b[i, 0])

        v = x * (1 + sc_f) + sh_f
        tok = v.reshape(-1, v.shape[-1])
        if not last:
            h = layer_norm(DN_ALPHA * h + gc_m * yc, ln_g[i, 0], ln_b[i, 0])
            vc = h * (1 + scc_f) + shc_f
            tok = jnp.concatenate([tok, vc.reshape(-1, vc.shape[-1])], axis=0)
        f = moe_ffn(tok, router_w[i], router_b[i], e_w_gate[i], e_w_up[i], e_w_down[i],
                    s_w_gate[i], s_w_up[i], s_w_down[i])
        x = layer_norm(DN_ALPHA * x + g_f * f[:n_lat].reshape(x.shape), ln_g[i, 1], ln_b[i, 1])
        if not last:
            h = layer_norm(DN_ALPHA * h + gc_f * f[n_lat:].reshape(h.shape), ln_g[i, 1], ln_b[i, 1])
    return x
```

```cpp
#include <hip/hip_runtime.h>
#include <cstdio>
#include <cstdint>

#ifndef MK_PER_PHASE
#define MK_PER_PHASE 1
#endif

#define GAS __attribute__((address_space(1)))
#define LAS __attribute__((address_space(3)))
typedef unsigned short bf16;
typedef short bf16x8 __attribute__((ext_vector_type(8)));
typedef short s16x4 __attribute__((ext_vector_type(4)));
typedef float f32x4 __attribute__((ext_vector_type(4)));
typedef float f32x2 __attribute__((ext_vector_type(2)));
typedef float f32x16 __attribute__((ext_vector_type(16)));
typedef unsigned u32x4 __attribute__((ext_vector_type(4)));
typedef unsigned u32x2 __attribute__((ext_vector_type(2)));
#define RLX_AGENT __ATOMIC_RELAXED, __HIP_MEMORY_SCOPE_AGENT
#define LDS_WAIT() asm volatile("s_waitcnt lgkmcnt(0)" ::: "memory")
#define SBAR() __builtin_amdgcn_sched_barrier(0)

__device__ __forceinline__ unsigned cvt_pk_bf16(float lo, float hi) { unsigned r; asm volatile("v_cvt_pk_bf16_f32 %0, %1, %2" : "=v"(r) : "v"(lo), "v"(hi)); return r; }
__device__ __forceinline__ float bf_lo(unsigned w) { return __uint_as_float(w << 16); }
__device__ __forceinline__ float bf_hi(unsigned w) { return __uint_as_float(w & 0xffff0000u); }
__device__ __forceinline__ float bf2f(bf16 v) { return __uint_as_float(((unsigned)v) << 16); }
__device__ __forceinline__ unsigned f2bf(float f) { unsigned u = __float_as_uint(f); return (u + 0x7fffu + ((u >> 16) & 1u)) >> 16; }
__device__ __forceinline__ float wave_sum(float v) {
#pragma unroll
    for (int o = 1; o < 64; o <<= 1) v += __shfl_xor(v, o);
    return v;
}

namespace pg8 {
constexpr int BM = 256, BK = 64, HALF = 128, HTB = HALF * BK * 2, STAGE_BYTES = 8 * HTB, NXCD = 8, WGM = 8;
__host__ __device__ __forceinline__ int lds_byte(int r, int c) { const int st = (r >> 4) * 2 + (c >> 5), rr = r & 15, cc = c & 31, ob = rr * 64 + cc * 2; return st * 1024 + (ob ^ (((ob >> 9) & 1) << 5)); }
__host__ __device__ __forceinline__ void stage_rc(int b, int& R, int& C) { const int st = b / 1024, sb = b % 1024, swz = sb ^ (((sb >> 9) & 1) << 5); R = (st >> 1) * 16 + swz / 64; C = (st & 1) * 32 + (swz % 64) / 2; }
__host__ __device__ __forceinline__ int perm32(int rho) { const int n = rho >> 4, i = rho & 15; return 8 * (i >> 2) + 4 * n + (i & 3); }

struct Unit { int pm, pn; };
struct Gemm { const bf16* A; const bf16* Bt; int K; };

__device__ __forceinline__ int xcd_remap(int wgid, int nwg) { const int q = nwg / NXCD, r = nwg % NXCD, xcd = wgid % NXCD, off = wgid / NXCD; return (xcd < r ? xcd * (q + 1) : r * (q + 1) + (xcd - r) * q) + off; }
__device__ __forceinline__ void tile_of(int wgid, int nM, int nN, int& pm, int& pn) {
    const int nig = WGM * nN, gid = wgid / nig, fm = gid * WGM, gsz = (nM - fm) < WGM ? (nM - fm) : WGM;
    pm = fm + ((wgid % nig) % gsz); pn = (wgid % nig) / gsz;
}

template <class Epi, class Sched, bool ALIGN_EPI = true, bool SP2 = true>
__device__ __forceinline__ void gemm_phase(LAS unsigned char* lds, const Gemm g, const Sched& S, const Epi& E) {
    const int tid = threadIdx.x, wid = __builtin_amdgcn_readfirstlane(tid >> 6), lane = tid & 63, wr = wid >> 2, wc = wid & 3, fr = lane & 15, fq = lane >> 4;
    const int K = g.K, nt = K / BK;
    unsigned voffA[2], voffB[2];
#pragma unroll
    for (int i = 0; i < 2; ++i) { int R, C; stage_rc(tid * 16 + i * 8192, R, C); const int Rb = (R & ~31) + perm32(R & 31);
        voffA[i] = (unsigned)(R * K + C) * 2u; voffB[i] = (unsigned)(Rb * K + C) * 2u; }
    const size_t kstep = (size_t)(BK * 2);
    const size_t hstep = (size_t)HALF * K * 2;
    const size_t tstep = 2 * hstep;
    const unsigned ldsw = (unsigned)wid * 1024u;
    const int aoff = lds_byte(wr * 64 + fr, fq * 8), boff = lds_byte(wc * 32 + fr, fq * 8);
#define PG8_SA(b, h) (((b) * 2 + (h)) * HTB)
#define PG8_SB(b, h) ((4 + (b) * 2 + (h)) * HTB)
#define PG8_STAGE(bufoff, gbase, voff) do { _Pragma("unroll") for (int _i = 0; _i < 2; ++_i) \
        __builtin_amdgcn_global_load_lds((const unsigned*)((const char*)(gbase) + (voff)[_i]), (LAS unsigned*)(lds + (bufoff) + ldsw + _i * 8192), 16, 0, 0); } while (0)
#define PG8_LDA(dst, b, h) do { _Pragma("unroll") for (int m = 0; m < 4; ++m) _Pragma("unroll") for (int k = 0; k < 2; ++k) dst[m][k] = *(const LAS bf16x8*)(lds + PG8_SA(b, h) + aoff + m * 2048 + k * 1024); } while (0)
#define PG8_LDB(dst, b, h) do { _Pragma("unroll") for (int n = 0; n < 2; ++n) _Pragma("unroll") for (int k = 0; k < 2; ++k) dst[n][k] = *(const LAS bf16x8*)(lds + PG8_SB(b, h) + boff + n * 2048 + k * 1024); } while (0)
#define PG8_MMA(ai, bj, At, Bt) do { __builtin_amdgcn_s_setprio(1); _Pragma("unroll") for (int m = 0; m < 4; ++m) _Pragma("unroll") for (int n = 0; n < 2; ++n) _Pragma("unroll") for (int k = 0; k < 2; ++k) \
        acc[ai][bj][m][n] = __builtin_amdgcn_mfma_f32_16x16x32_bf16(Bt[n][k], At[m][k], acc[ai][bj][m][n], 0, 0, 0); __builtin_amdgcn_s_setprio(0); } while (0)
#define PG8_WAIT_V(n) asm volatile("s_waitcnt vmcnt(" #n ")" ::: "memory")
#define PG8_WAIT_L(n) asm volatile("s_waitcnt lgkmcnt(" #n ")" ::: "memory")
#define PG8_BAR __builtin_amdgcn_s_barrier()
#define PG8_SCHED __builtin_amdgcn_sched_barrier(0)
    Unit cur, nxt; int ui = 0;
    if (!S.next(0, cur)) return;
    f32x4 acc[2][2][4][2];
#pragma unroll
    for (int a = 0; a < 2; ++a)
#pragma unroll
        for (int b = 0; b < 2; ++b)
#pragma unroll
            for (int m = 0; m < 4; ++m)
#pragma unroll
                for (int n = 0; n < 2; ++n) acc[a][b][m][n] = (f32x4){0.f, 0.f, 0.f, 0.f};
    bf16x8 At[4][2], B0[2][2], B1[2][2];
    const char* cA = (const char*)g.A + (size_t)cur.pm * tstep; const char* cB = (const char*)g.Bt + (size_t)cur.pn * tstep;
    if constexpr (SP2) {
        PG8_STAGE(PG8_SB(0, 0), cB, voffB); PG8_STAGE(PG8_SB(0, 1), cB + hstep, voffB); PG8_STAGE(PG8_SA(0, 0), cA, voffA); PG8_STAGE(PG8_SA(0, 1), cA + hstep, voffA);
        if (wr == 1) PG8_BAR;
        PG8_WAIT_V(2); PG8_BAR;
        PG8_STAGE(PG8_SB(1, 0), cB + kstep, voffB); PG8_STAGE(PG8_SA(1, 0), cA + kstep, voffA); PG8_STAGE(PG8_SB(1, 1), cB + hstep + kstep, voffB);
        PG8_WAIT_V(6); PG8_BAR;
    } else {
        PG8_STAGE(PG8_SB(0, 0), cB, voffB); PG8_STAGE(PG8_SA(0, 0), cA, voffA); PG8_STAGE(PG8_SB(0, 1), cB + hstep, voffB); PG8_STAGE(PG8_SA(0, 1), cA + hstep, voffA);
        if (wr == 1) PG8_BAR;
        PG8_WAIT_V(4); PG8_BAR;
        PG8_STAGE(PG8_SB(1, 0), cB + kstep, voffB); PG8_STAGE(PG8_SA(1, 0), cA + kstep, voffA); PG8_STAGE(PG8_SB(1, 1), cB + hstep + kstep, voffB);
        PG8_WAIT_V(6); PG8_BAR;
    }
    for (;;) {
        const bool has_next = S.next(ui + 1, nxt);
        const char* nA = has_next ? (const char*)g.A + (size_t)nxt.pm * tstep : cA; const char* nB = has_next ? (const char*)g.Bt + (size_t)nxt.pn * tstep : cB;
        for (int t = 0; t < nt; t += 2) {
            const bool last = (t == nt - 2);
            const char* a1 = cA + (size_t)(t + 1) * kstep;
            const char* a2 = last ? nA : cA + (size_t)(t + 2) * kstep; const char* b2 = last ? nB : cB + (size_t)(t + 2) * kstep;
            const char* a3 = a2 + kstep; const char* b3 = b2 + kstep;
            if constexpr (SP2) {
            PG8_LDB(B0, 0, 0); PG8_LDB(B1, 0, 1); PG8_SCHED; PG8_LDA(At, 0, 0); PG8_STAGE(PG8_SA(1, 1), a1 + hstep, voffA);
            PG8_WAIT_V(8); PG8_WAIT_L(0); PG8_BAR; PG8_MMA(0, 0, At, B0); PG8_MMA(0, 1, At, B1); PG8_BAR; PG8_SCHED;
            PG8_LDA(At, 0, 1); PG8_STAGE(PG8_SB(0, 0), b2, voffB); PG8_STAGE(PG8_SB(0, 1), b2 + hstep, voffB); PG8_STAGE(PG8_SA(0, 0), a2, voffA);
            PG8_WAIT_V(8); PG8_WAIT_L(0); PG8_BAR; PG8_MMA(1, 0, At, B0); PG8_MMA(1, 1, At, B1); PG8_BAR; PG8_SCHED;
            PG8_LDB(B0, 1, 0); PG8_LDB(B1, 1, 1); PG8_SCHED; PG8_LDA(At, 1, 0); PG8_STAGE(PG8_SA(0, 1), a2 + hstep, voffA);
            PG8_WAIT_V(8); PG8_WAIT_L(0); PG8_BAR; PG8_MMA(0, 0, At, B0); PG8_MMA(0, 1, At, B1); PG8_BAR; PG8_SCHED;
            PG8_LDA(At, 1, 1); PG8_STAGE(PG8_SB(1, 0), b3, voffB); PG8_STAGE(PG8_SB(1, 1), b3 + hstep, voffB); PG8_STAGE(PG8_SA(1, 0), a3, voffA);
            PG8_WAIT_V(8); PG8_WAIT_L(0); PG8_BAR; PG8_MMA(1, 0, At, B0); PG8_MMA(1, 1, At, B1); PG8_BAR; PG8_SCHED;
            } else {
            PG8_LDB(B0, 0, 0); PG8_SCHED; PG8_LDA(At, 0, 0); PG8_STAGE(PG8_SA(1, 1), a1 + hstep, voffA);
            PG8_WAIT_L(8); PG8_BAR; PG8_WAIT_L(0); PG8_MMA(0, 0, At, B0); PG8_BAR; PG8_SCHED;
            PG8_LDB(B1, 0, 1); PG8_STAGE(PG8_SB(0, 0), b2, voffB);
            PG8_BAR; PG8_WAIT_L(0); PG8_MMA(0, 1, At, B1); PG8_BAR;
            PG8_LDA(At, 0, 1); PG8_STAGE(PG8_SA(0, 0), a2, voffA);
            PG8_BAR; PG8_WAIT_L(0); PG8_MMA(1, 0, At, B0); PG8_BAR; PG8_SCHED;
            PG8_STAGE(PG8_SB(0, 1), b2 + hstep, voffB);
            PG8_WAIT_V(6); PG8_BAR; PG8_MMA(1, 1, At, B1); PG8_BAR;
            PG8_LDB(B0, 1, 0); PG8_SCHED; PG8_LDA(At, 1, 0); PG8_STAGE(PG8_SA(0, 1), a2 + hstep, voffA);
            PG8_WAIT_L(8); PG8_BAR; PG8_WAIT_L(0); PG8_MMA(0, 0, At, B0); PG8_BAR; PG8_SCHED;
            PG8_LDB(B1, 1, 1); PG8_STAGE(PG8_SB(1, 0), b3, voffB);
            PG8_BAR; PG8_WAIT_L(0); PG8_MMA(0, 1, At, B1); PG8_BAR;
            PG8_LDA(At, 1, 1); PG8_STAGE(PG8_SA(1, 0), a3, voffA);
            PG8_BAR; PG8_WAIT_L(0); PG8_MMA(1, 0, At, B0); PG8_BAR; PG8_SCHED;
            PG8_STAGE(PG8_SB(1, 1), b3 + hstep, voffB);
            PG8_WAIT_V(6); PG8_BAR; PG8_MMA(1, 1, At, B1); PG8_BAR;
            }
        }
        if constexpr (ALIGN_EPI) { if (wr == 0) PG8_BAR; }
        E(acc, cur, wr, wc, fr, fq);
        if (!has_next) break;
#pragma unroll
        for (int a = 0; a < 2; ++a)
#pragma unroll
            for (int b = 0; b < 2; ++b)
#pragma unroll
                for (int m = 0; m < 4; ++m)
#pragma unroll
                    for (int n = 0; n < 2; ++n) acc[a][b][m][n] = (f32x4){0.f, 0.f, 0.f, 0.f};
        cur = nxt; cA = nA; cB = nB; ++ui;
        if constexpr (ALIGN_EPI) { if (wr == 1) PG8_BAR; }
    }
    PG8_WAIT_V(0);
    if constexpr (!ALIGN_EPI) { if (wr == 0) PG8_BAR; }
    PG8_BAR;
#undef PG8_SA
#undef PG8_SB
#undef PG8_STAGE
#undef PG8_LDA
#undef PG8_LDB
#undef PG8_MMA
#undef PG8_WAIT_V
#undef PG8_WAIT_L
#undef PG8_BAR
#undef PG8_SCHED
}
}

constexpr int DM = 2048, NB = 4, SEQ = 4096, CL = 256, RPB = SEQ + CL, MROWS = NB * RPB, MT = MROWS / 256;
constexpr int NE = 64, FF = 512, A_IN = 4608;
constexpr int XS_BLK = 472, SH_BLK = 68;
constexpr float DN_ALPHA = 1.4142135623730951f;
constexpr float LN_EPS = 1e-5f, RMS_EPS = 1e-6f;

constexpr size_t MiB = 1u << 20;
constexpr size_t WS_CTL = 0, CTL_ZERO_BYTES = 1 * MiB;
constexpr size_t WS_MOD = 1 * MiB;
constexpr size_t WS_ROPE128 = 2 * MiB;
constexpr size_t WS_ROPE64 = 4 * MiB;
constexpr size_t WS_TE = 5 * MiB;
constexpr size_t WS_TW = 6 * MiB;
constexpr size_t WS_INV = 7 * MiB;
constexpr size_t WS_BLKE = 7 * MiB + 768 * 1024;
constexpr size_t WS_W_IN = 8 * MiB;
constexpr size_t WS_W_OUT0 = 26 * MiB;
constexpr size_t WS_W_DOWN = 34 * MiB;
constexpr size_t WS_W_UQKV = 39 * MiB;
constexpr size_t WS_W_OUT1 = 46 * MiB;
constexpr size_t WS_W_RT = 54 * MiB;
constexpr size_t WS_W_GU = 56 * MiB;
constexpr size_t WS_W_D = 576 * MiB;
constexpr size_t WS_X = 836 * MiB;
constexpr size_t WS_UM = 972 * MiB;
constexpr size_t WS_XS = 1040 * MiB;
constexpr size_t WS_U = WS_XS + (size_t)XS_BLK * MiB;
constexpr size_t WS_ULO = WS_U + (size_t)SH_BLK * MiB;
constexpr size_t WS_Y = WS_XS;
constexpr size_t WS_H = 1648 * MiB;
constexpr size_t WS_PROJ = 1783 * MiB;
constexpr size_t WS_Y1_0 = WS_PROJ;
constexpr size_t WS_MIX = 1936 * MiB;
constexpr size_t WS_LOG = 2004 * MiB;
constexpr size_t WS_END = 2021 * MiB;
constexpr size_t WS_DOWNP = 1040 * MiB;
constexpr size_t WS_CQKV = 1083 * MiB;
constexpr size_t WS_KR = 1117 * MiB;
constexpr size_t WS_QB = 1120 * MiB;
constexpr size_t WS_KVB = 1222 * MiB;
constexpr size_t WS_ATT = 1358 * MiB;
constexpr size_t WS_Y1_1 = 1426 * MiB;
static_assert(WS_Y1_1 + 68 * MiB <= WS_U, "layer-1 mixer buffers inside XS");
constexpr size_t W_GU_L = (size_t)65 * 1024 * 2048, W_D_L = (size_t)65 * 2048 * 512;

constexpr int CW_TMO = 0, CW_BAR = 4096, CW_CNT = 8192, CW_NBLK = 8192 + 256;

constexpr int LDS_BYTES = 155648, RING_BYTES = 147456, MISC_OFF = RING_BYTES + 320;

#define XB_TMO      128
#define XB_XCNT(j)  (256  + 64 * (j))
#define XB_XSUB(j)  (1280 + 64 * (j))
#define XB_XGEN(j)  (2304 + 64 * (j))
#define XB_TOP      3328
#define XB_TOPGEN   3392
#define XCD_BAR_WORDS 3456
#define XB_SPIN_CAP (1u << 18)
__device__ __forceinline__ unsigned xb_ld(unsigned* p)              { return __hip_atomic_load(p, __ATOMIC_RELAXED, __HIP_MEMORY_SCOPE_AGENT); }
__device__ __forceinline__ unsigned xb_add(unsigned* p, unsigned v) { return __hip_atomic_fetch_add(p, v, __ATOMIC_RELAXED, __HIP_MEMORY_SCOPE_AGENT); }
__device__ __forceinline__ unsigned xb_xcc_id() { return (unsigned)__builtin_amdgcn_s_getreg((3 << 11) | 20) & 0xFu; }
#define XB_SPIN(cond, bar) do { unsigned _sp = 0; while (cond) { __builtin_amdgcn_s_sleep(1); \
    if ((++_sp & 255u) == 0u) { if (xb_ld(&(bar)[XB_TMO])) break; if (_sp > XB_SPIN_CAP) { atomicAdd(&(bar)[XB_TMO], 1u); break; } } } } while (0)
struct XcdBarrier { unsigned* bar; unsigned x; volatile LAS unsigned* st; };
__device__ __forceinline__ XcdBarrier xcd_barrier_post(unsigned* bar, volatile LAS unsigned* st) {
    XcdBarrier b; b.bar = bar; b.x = xb_xcc_id(); b.st = st;
    if (threadIdx.x == 0) (void)xb_add(&bar[XB_XCNT(b.x)], 1u);
    return b;
}
__device__ __forceinline__ void xcd_barrier_complete(unsigned* bar, unsigned x, unsigned& nloc, unsigned& nx) {
    const unsigned G = gridDim.x * gridDim.y * gridDim.z;
    unsigned sum, cnt, mine, sp = 0u;
    for (;;) {
        sum = 0u; cnt = 0u; mine = 0u;
#pragma unroll
        for (unsigned j = 0; j < 16; ++j) { const unsigned c = xb_ld(&bar[XB_XCNT(j)]); sum += c; cnt += (c > 0u) ? 1u : 0u; mine = (j == x) ? c : mine; }
        if (sum == G) break;
        __builtin_amdgcn_s_sleep(1);
        if ((++sp & 255u) == 0u) { if (xb_ld(&bar[XB_TMO])) break; if (sp > XB_SPIN_CAP) { atomicAdd(&bar[XB_TMO], 1u); break; } }
    }
    nloc = mine > 0u ? mine : 1u; nx = cnt > 0u ? cnt : 1u;
}
__device__ __forceinline__ void xcd_barrier(const XcdBarrier& b) {
    asm volatile("s_waitcnt vmcnt(0)" ::: "memory");
    __syncthreads();
    if (threadIdx.x == 0) {
        unsigned* bar = b.bar;
        __builtin_amdgcn_s_waitcnt(0);
        unsigned nloc = b.st[0], nx = b.st[1];
        if (nloc == 0u) { xcd_barrier_complete(bar, b.x, nloc, nx); b.st[0] = nloc; b.st[1] = nx; }
        const unsigned old = xb_add(&bar[XB_XSUB(b.x)], 1u);
        const unsigned gen = old / nloc;
        if (old + 1u == (gen + 1u) * nloc) {
            __builtin_amdgcn_fence(__ATOMIC_RELEASE, "agent");
            asm volatile("s_waitcnt vmcnt(0)" ::: "memory");
            const unsigned og = xb_add(&bar[XB_TOP], 1u);
            const unsigned tg = og / nx;
            if (og + 1u == (tg + 1u) * nx) xb_add(&bar[XB_TOPGEN], 1u);
            else XB_SPIN(xb_ld(&bar[XB_TOPGEN]) == tg, bar);
            __builtin_amdgcn_fence(__ATOMIC_ACQUIRE, "agent");
            xb_add(&bar[XB_XGEN(b.x)], 1u);
            asm volatile("s_waitcnt vmcnt(0)" ::: "memory");
        } else {
            XB_SPIN(xb_ld(&bar[XB_XGEN(b.x)]) == gen, bar);
            __builtin_amdgcn_fence(__ATOMIC_ACQUIRE, "agent");
            asm volatile("s_waitcnt vmcnt(0)" ::: "memory");
        }
    }
    __syncthreads();
}

struct Args { const float* in[27]; float* out; unsigned char* ws; int ph_lo, ph_hi; };
enum { I_X = 0, I_C, I_CTX, I_CCTX, I_WADA, I_BADA, I_LNG, I_LNB, I_AWIN, I_ACONV, I_AQG, I_AKG, I_AWOUT, I_MWDOWN, I_MQG, I_MKVG, I_MWUQ, I_MWUKV, I_MWOUT,
       I_RW, I_RB, I_EWG, I_EWU, I_EWD, I_SWG, I_SWU, I_SWD };

struct Ctx {
    LAS unsigned char* lds; int tid, lane, wave, G, bid, vcu, gw, ngw;
    unsigned char* ws; unsigned* ctl;
};
__device__ __forceinline__ void row_info(int r, int& b, int& p) { b = r / RPB; p = r - b * RPB; }
__device__ __forceinline__ const float* in_row(const Args& a, int b, int p) {
    return p < CL ? a.in[I_CTX] + ((size_t)(b * CL + p)) * DM : a.in[I_X] + ((size_t)(b * SEQ + (p - CL))) * DM;
}

template <bool SPLIT>
__device__ __forceinline__ void tr_item(const float* __restrict__ src, int ldw, bf16* dst, bf16* dst_lo, int ldd, LAS float* scr, int lane) {
#pragma unroll 8
    for (int i = 0; i < 32; ++i) { const int kk = 2 * i + (lane >> 5); scr[kk * 33 + (lane & 31)] = src[(size_t)kk * ldw + (lane & 31)]; }
    LDS_WAIT(); asm volatile("" ::: "memory");
    const int c = lane & 7;
#pragma unroll
    for (int j = 0; j < 4; ++j) { const int n = (lane >> 3) + 8 * j; const LAS float* s = scr + (8 * c) * 33 + n;
        float v[8];
#pragma unroll
        for (int q = 0; q < 8; ++q) v[q] = s[q * 33];
        u32x4 o; o.x = cvt_pk_bf16(v[0], v[1]); o.y = cvt_pk_bf16(v[2], v[3]); o.z = cvt_pk_bf16(v[4], v[5]); o.w = cvt_pk_bf16(v[6], v[7]);
        *(u32x4*)(dst + (size_t)n * ldd + 8 * c) = o;
        if constexpr (SPLIT) {
            u32x4 l; l.x = cvt_pk_bf16(v[0] - bf_lo(o.x), v[1] - bf_hi(o.x)); l.y = cvt_pk_bf16(v[2] - bf_lo(o.y), v[3] - bf_hi(o.y));
            l.z = cvt_pk_bf16(v[4] - bf_lo(o.z), v[5] - bf_hi(o.z)); l.w = cvt_pk_bf16(v[6] - bf_lo(o.w), v[7] - bf_hi(o.w));
            *(u32x4*)(dst_lo + (size_t)n * ldd + 8 * c) = l;
        }
    }
    LDS_WAIT(); asm volatile("" ::: "memory");
}

__device__ __forceinline__ void p0_prologue(const Ctx& C, const Args& a) {
    unsigned char* ws = C.ws;
    {
        LAS float* sv = (LAS float*)C.lds;
        LAS float* red = (LAS float*)(C.lds + 40960);
        for (int i = C.tid; i < 5 * DM; i += 512) { const int r = i / DM, k = i - r * DM; const float c = (r < 4) ? a.in[I_C][r * DM + k] : a.in[I_CCTX][k]; sv[i] = c / (1.f + __expf(-c)); }
        __syncthreads();
        float* mod = (float*)(ws + WS_MOD);
        for (int chunk = C.bid; chunk < 256; chunk += C.G) {
            const int l = chunk >> 7, col0 = (chunk & 127) * 96;
            if (C.tid < 384) {
                const int cg = C.tid % 24, ks = C.tid / 24;
                f32x4 acc[5];
#pragma unroll
                for (int r = 0; r < 5; ++r) acc[r] = (f32x4){0.f, 0.f, 0.f, 0.f};
                const float* W = a.in[I_WADA] + ((size_t)l * DM + ks * 128) * 12288 + col0 + 4 * cg;
                const LAS float* s0 = sv + ks * 128;
#pragma unroll 8
                for (int k = 0; k < 128; ++k) { const f32x4 w = *(const f32x4*)(W + (size_t)k * 12288);
#pragma unroll
                    for (int r = 0; r < 5; ++r) { const float s = s0[r * DM + k]; acc[r] += w * s; } }
#pragma unroll
                for (int r = 0; r < 5; ++r) *(LAS f32x4*)(red + (ks * 5 + r) * 96 + 4 * cg) = acc[r];
            }
            __syncthreads();
            if (C.tid < 480) { const int r = C.tid / 96, c = C.tid - r * 96; float s = a.in[I_BADA][l * 12288 + col0 + c];
#pragma unroll
                for (int ks = 0; ks < 16; ++ks) s += red[(ks * 5 + r) * 96 + c];
                mod[((size_t)l * 5 + r) * 12288 + col0 + c] = s; }
            __syncthreads();
        }
    }
    {
        f32x2* r128 = (f32x2*)(ws + WS_ROPE128); f32x2* r64 = (f32x2*)(ws + WS_ROPE64);
        const int gt = C.bid * 512 + C.tid, ngt = C.G * 512;
        for (int i = gt; i < SEQ * 64; i += ngt) { const int s = i >> 6, j = i & 63; const float pos = (float)((j < 32) ? (s >> 6) : (s & 63)); const int f = j & 31;
            const float inv = exp2f(-(float)f * (13.287712379549449f / 32.f)); const float ang = pos * inv; r128[i] = (f32x2){cosf(ang), sinf(ang)}; }
        for (int i = gt; i < SEQ * 32; i += ngt) { const int s = i >> 5, j = i & 31; const float pos = (float)((j < 16) ? (s >> 6) : (s & 63)); const int f = j & 15;
            const float inv = exp2f(-(float)f * (13.287712379549449f / 16.f)); const float ang = pos * inv; r64[i] = (f32x2){cosf(ang), sinf(ang)}; }
        const u32x4 z = {0u, 0u, 0u, 0u};
        u32x4* zd = (u32x4*)(ws + WS_W_DOWN + (size_t)1088 * 4096);
        for (int i = gt; i < 192 * 256; i += ngt) zd[i] = z;
        for (int l = 0; l < 2; ++l) { u32x4* zr = (u32x4*)(ws + WS_W_RT + (size_t)l * 256 * 4096 + (size_t)128 * 4096); for (int i = gt; i < 128 * 256; i += ngt) zr[i] = z; }
    }
    __syncthreads();
    {
        LAS float* scr = (LAS float*)(C.lds + C.wave * 16384);
        constexpr int J0 = 32 * 144, J1 = 32 * 64, J2 = 32 * 34, J3 = 8 * 96, J4 = 8 * 128, J5 = 32 * 64, J6 = 2 * 32 * 2, J7 = 2 * 64 * 512, J8 = J7, J9 = 2 * 64 * 512, J10 = 2 * 512, J11 = J10, J12 = 2 * 512;
        constexpr int NITEMS = J0 + J1 + J2 + J3 + J4 + J5 + J6 + J7 + J8 + J9 + J10 + J11 + J12;
        bf16* w_in = (bf16*)(ws + WS_W_IN); bf16* w_out0 = (bf16*)(ws + WS_W_OUT0); bf16* w_down = (bf16*)(ws + WS_W_DOWN); bf16* w_uqkv = (bf16*)(ws + WS_W_UQKV);
        bf16* w_out1 = (bf16*)(ws + WS_W_OUT1); bf16* w_rt = (bf16*)(ws + WS_W_RT); bf16* w_gu = (bf16*)(ws + WS_W_GU); bf16* w_d = (bf16*)(ws + WS_W_D);
        for (int it = C.gw; it < NITEMS; it += C.ngw) {
            int r = it;
            if (r < J0) { const int kb = r / 144, nb = r % 144; tr_item<false>(a.in[I_AWIN] + (size_t)kb * 64 * A_IN + nb * 32, A_IN, w_in + (size_t)nb * 32 * DM + kb * 64, nullptr, DM, scr, C.lane); continue; } r -= J0;
            if (r < J1) { const int kb = r / 64, nb = r % 64; tr_item<false>(a.in[I_AWOUT] + (size_t)kb * 64 * DM + nb * 32, DM, w_out0 + (size_t)nb * 32 * DM + kb * 64, nullptr, DM, scr, C.lane); continue; } r -= J1;
            if (r < J2) { const int kb = r / 34, nb = r % 34; tr_item<false>(a.in[I_MWDOWN] + (size_t)kb * 64 * 1088 + nb * 32, 1088, w_down + (size_t)nb * 32 * DM + kb * 64, nullptr, DM, scr, C.lane); continue; } r -= J2;
            if (r < J3) { const int kb = r / 96, nb = r % 96; const int n0 = nb * 32, h = n0 / 192, d = n0 - h * 192;
                const int row = (d < 128) ? (128 * h + d) : (2048 + 256 * (h >> 2) + ((d - 128) ? 128 : 0) + 32 * (h & 3));
                tr_item<false>(a.in[I_MWUQ] + (size_t)kb * 64 * 3072 + n0, 3072, w_uqkv + (size_t)row * 512 + kb * 64, nullptr, 512, scr, C.lane); continue; } r -= J3;
            if (r < J4) { const int kb = r / 128, nb = r % 128; tr_item<false>(a.in[I_MWUKV] + (size_t)kb * 64 * 4096 + nb * 32, 4096, w_uqkv + (size_t)(3072 + nb * 32) * 512 + kb * 64, nullptr, 512, scr, C.lane); continue; } r -= J4;
            if (r < J5) { const int kb = r / 64, nb = r % 64; tr_item<false>(a.in[I_MWOUT] + (size_t)kb * 64 * DM + nb * 32, DM, w_out1 + (size_t)nb * 32 * DM + kb * 64, nullptr, DM, scr, C.lane); continue; } r -= J5;
            if (r < J6) { const int l = r / 64, q = r % 64, kb = q / 2, nb = q % 2; bf16* d = w_rt + (size_t)l * 256 * DM + (size_t)nb * 32 * DM + kb * 64;
                tr_item<true>(a.in[I_RW] + ((size_t)l * DM + kb * 64) * 64 + nb * 32, 64, d, d + (size_t)64 * DM, DM, scr, C.lane); continue; } r -= J6;
            if (r < J7 + J8) { const int up = r >= J7; if (up) r -= J7; const int le = r / 512, q = r % 512, kb = q / 16, nb = q % 16, n0 = nb * 32, l = le >> 6, e = le & 63;
                const float* src = (up ? a.in[I_EWU] : a.in[I_EWG]) + ((size_t)le * DM + kb * 64) * FF + n0;
                bf16* d = w_gu + (size_t)l * W_GU_L + ((size_t)e * 1024 + 256 * (n0 >> 7) + (up ? 128 : 0) + (n0 & 127)) * DM + kb * 64;
                tr_item<false>(src, FF, d, nullptr, DM, scr, C.lane); continue; } r -= J7 + J8;
            if (r < J9) { const int le = r / 512, q = r % 512, kb = q / 64, nb = q % 64, l = le >> 6, e = le & 63;
                tr_item<false>(a.in[I_EWD] + ((size_t)le * FF + kb * 64) * DM + nb * 32, DM, w_d + (size_t)l * W_D_L + ((size_t)e * 2048 + nb * 32) * FF + kb * 64, nullptr, FF, scr, C.lane); continue; } r -= J9;
            if (r < J10 + J11) { const int up = r >= J10; if (up) r -= J10; const int l = r / 512, q = r % 512, kb = q / 16, nb = q % 16, n0 = nb * 32;
                const float* src = (up ? a.in[I_SWU] : a.in[I_SWG]) + ((size_t)l * DM + kb * 64) * FF + n0;
                bf16* d = w_gu + (size_t)l * W_GU_L + ((size_t)NE * 1024 + 256 * (n0 >> 7) + (up ? 128 : 0) + (n0 & 127)) * DM + kb * 64;
                tr_item<false>(src, FF, d, nullptr, DM, scr, C.lane); continue; } r -= J10 + J11;
            { const int l = r / 512, q = r % 512, kb = q / 64, nb = q % 64;
                tr_item<false>(a.in[I_SWD] + ((size_t)l * FF + kb * 64) * DM + nb * 32, DM, w_d + (size_t)l * W_D_L + ((size_t)NE * 2048 + nb * 32) * FF + kb * 64, nullptr, FF, scr, C.lane); }
        }
    }
}

__device__ __forceinline__ void p1_modulate0(const Ctx& C, const Args& a) {
    const float* mod = (const float*)(C.ws + WS_MOD); bf16* um = (bf16*)(C.ws + WS_UM);
    for (int r = C.gw; r < MROWS; r += C.ngw) {
        int b, p; row_info(r, b, p); const float* xr = in_row(a, b, p); const float* mr = mod + (size_t)(p < CL ? 4 : b) * 12288;
#pragma unroll
        for (int j = 0; j < 8; ++j) { const int e = 4 * (C.lane + 64 * j); const f32x4 x = *(const f32x4*)(xr + e), sh = *(const f32x4*)(mr + e), sc = *(const f32x4*)(mr + 2048 + e);
            const f32x4 u = x * (sc + 1.f) + sh; u32x2 w; w.x = cvt_pk_bf16(u[0], u[1]); w.y = cvt_pk_bf16(u[2], u[3]); *(u32x2*)(um + (size_t)r * DM + e) = w; }
    }
}

struct EpiStoreBf16 {
    bf16* O; int ldc;
    __device__ __forceinline__ void operator()(const f32x4 (&acc)[2][2][4][2], const pg8::Unit& u, int wr, int wc, int fr, int fq) const {
        const int row0 = u.pm * 256 + wr * 64 + fr, col0 = u.pn * 256 + wc * 32 + 8 * fq;
#pragma unroll
        for (int ai = 0; ai < 2; ++ai)
#pragma unroll
            for (int m = 0; m < 4; ++m) { bf16* rowp = O + (size_t)(row0 + ai * 128 + m * 16) * ldc + col0;
#pragma unroll
                for (int bj = 0; bj < 2; ++bj) { const f32x4 v0 = acc[ai][bj][m][0], v1 = acc[ai][bj][m][1];
                    u32x4 w; w.x = cvt_pk_bf16(v0[0], v0[1]); w.y = cvt_pk_bf16(v0[2], v0[3]); w.z = cvt_pk_bf16(v1[0], v1[1]); w.w = cvt_pk_bf16(v1[2], v1[3]);
                    *(u32x4*)(rowp + bj * 128) = w; } }
    }
};
struct DenseSched {
    int nM, nN, G, c, lat_only, pm_off, pn_off;
    __device__ __forceinline__ bool next(int i, pg8::Unit& u) const {
        const long L = (long)i * G + c; const int nwg = nM * nN; if (L >= nwg) return false;
        const int w = pg8::xcd_remap((int)L, nwg); int pm, pn; pg8::tile_of(w, nM, nN, pm, pn);
        if (lat_only) pm = 17 * (pm >> 4) + 1 + (pm & 15);
        u.pm = pm + pm_off; u.pn = pn + pn_off; return true;
    }
};

__device__ __forceinline__ void p3_qk_conv(const Ctx& C, const Args& a) {
    bf16* proj = (bf16*)(C.ws + WS_PROJ); bf16* mix = (bf16*)(C.ws + WS_MIX);
    const f32x2* rope = (const f32x2*)(C.ws + WS_ROPE128);
    const float qg0 = a.in[I_AQG][C.lane], qg1 = a.in[I_AQG][C.lane + 64], kg0 = a.in[I_AKG][C.lane], kg1 = a.in[I_AKG][C.lane + 64];
    const float* cw = a.in[I_ACONV];
    for (int r = C.gw; r < MROWS; r += C.ngw) {
        int b, p; row_info(r, b, p); const bool isctx = p < CL;
        bf16* pr = proj + (size_t)r * A_IN;
        f32x2 cs = {1.f, 0.f}; if (!isctx) cs = rope[(size_t)(p - CL) * 64 + C.lane];
#pragma unroll
        for (int h = 0; h < 10; ++h) {
            bf16* hp = pr + 3072 + 128 * h;
            const float x1 = bf2f(hp[C.lane]), x2 = bf2f(hp[C.lane + 64]);
            const float ss = wave_sum(x1 * x1 + x2 * x2);
            const float rs = 1.f / sqrtf(ss * (1.f / 128.f) + RMS_EPS);
            const float y1 = x1 * rs * (h < 8 ? qg0 : kg0), y2 = x2 * rs * (h < 8 ? qg1 : kg1);
            hp[C.lane] = (bf16)f2bf(y1 * cs.x - y2 * cs.y); hp[C.lane + 64] = (bf16)f2bf(y2 * cs.x + y1 * cs.y);
        }
        const int pos = isctx ? p : p - CL, len = isctx ? CL : SEQ;
        const bool hasm = pos > 0, hasp = pos + 1 < len;
#pragma unroll
        for (int j = 0; j < 2; ++j) {
            const int c0 = 8 * (C.lane + 64 * j);
            const u32x4 gb = *(const u32x4*)(pr + c0), gc = *(const u32x4*)(pr + 1024 + c0), hv = *(const u32x4*)(pr + 2048 + c0);
            u32x4 gcm = {0u, 0u, 0u, 0u}, hvm = gcm, gcp = gcm, hvp = gcm;
            if (hasm) { gcm = *(const u32x4*)(pr - A_IN + 1024 + c0); hvm = *(const u32x4*)(pr - A_IN + 2048 + c0); }
            if (hasp) { gcp = *(const u32x4*)(pr + A_IN + 1024 + c0); hvp = *(const u32x4*)(pr + A_IN + 2048 + c0); }
            const f32x4 w0a = *(const f32x4*)(cw + c0), w0b = *(const f32x4*)(cw + c0 + 4), w1a = *(const f32x4*)(cw + 1024 + c0), w1b = *(const f32x4*)(cw + 1024 + c0 + 4),
                        w2a = *(const f32x4*)(cw + 2048 + c0), w2b = *(const f32x4*)(cw + 2048 + c0 + 4);
            float o[8];
#pragma unroll
            for (int q = 0; q < 4; ++q) {
                const float w0l = q < 2 ? w0a[2 * q] : w0b[2 * q - 4], w0h = q < 2 ? w0a[2 * q + 1] : w0b[2 * q - 3];
                const float w1l = q < 2 ? w1a[2 * q] : w1b[2 * q - 4], w1h = q < 2 ? w1a[2 * q + 1] : w1b[2 * q - 3];
                const float w2l = q < 2 ? w2a[2 * q] : w2b[2 * q - 4], w2h = q < 2 ? w2a[2 * q + 1] : w2b[2 * q - 3];
                const float zl = bf_lo(gc[q]) * bf_lo(hv[q]), zh = bf_hi(gc[q]) * bf_hi(hv[q]);
                const float zml = bf_lo(gcm[q]) * bf_lo(hvm[q]), zmh = bf_hi(gcm[q]) * bf_hi(hvm[q]);
                const float zpl = bf_lo(gcp[q]) * bf_lo(hvp[q]), zph = bf_hi(gcp[q]) * bf_hi(hvp[q]);
                o[2 * q] = bf_lo(gb[q]) * (w0l * zml + w1l * zl + w2l * zpl);
                o[2 * q + 1] = bf_hi(gb[q]) * (w0h * zmh + w1h * zh + w2h * zph);
            }
            u32x4 w; w.x = cvt_pk_bf16(o[0], o[1]); w.y = cvt_pk_bf16(o[2], o[3]); w.z = cvt_pk_bf16(o[4], o[5]); w.w = cvt_pk_bf16(o[6], o[7]);
            *(u32x4*)(mix + (size_t)r * DM + c0) = w;
        }
    }
}

namespace att {
constexpr int NW = 8, QBLK = 32, KVBLK = 64;
constexpr int SHM_V = KVBLK * 128 * 2, SHM_K = KVBLK * 128 * 2, SHM_KR = KVBLK * 64 * 2;
constexpr int OFF_V = 0, OFF_K = 2 * SHM_V, OFF_KR = 2 * SHM_V + 2 * SHM_K, OFF_QR = OFF_KR + 2 * SHM_KR, LDS_ATT = OFF_QR + NW * 8192;
constexpr float THR = 8.f;
#define KSWZ(row, colB) ((row) * 256 + ((colB) ^ (((row) & 7) << 4)))
#define KRSWZ(row, colB) ((row) * 128 + ((colB) ^ (((row) & 7) << 4)))
__device__ __forceinline__ bf16x8 ld8(const bf16* p) { return *reinterpret_cast<const bf16x8*>(p); }

__device__ __forceinline__ void partialSM(f32x16& p0, f32x16& p1, float& m_reg, float& mn, float& alpha, const float SCALE) {
    const float Cc = SCALE * 1.4426950408889634f;
    float pmax = p0[0];
#pragma unroll
    for (int r = 1; r < 16; ++r) pmax = fmaxf(pmax, p0[r]);
#pragma unroll
    for (int r = 0; r < 16; ++r) pmax = fmaxf(pmax, p1[r]);
    { auto rr = __builtin_amdgcn_permlane32_swap(__float_as_uint(pmax), __float_as_uint(pmax), false, false);
      pmax = fmaxf(__uint_as_float(rr[0]), __uint_as_float(rr[1])); }
    if (__builtin_expect(__all(pmax - m_reg <= THR / SCALE), 1)) { mn = m_reg; alpha = 1.f; }
    else { mn = fmaxf(m_reg, pmax); alpha = __builtin_amdgcn_exp2f((m_reg - mn) * Cc); m_reg = mn; }
    const float mnC = -mn * Cc;
#pragma unroll
    for (int r = 0; r < 16; ++r) p0[r] = fmaf(p0[r], Cc, mnC);
#pragma unroll
    for (int r = 0; r < 16; ++r) p1[r] = fmaf(p1[r], Cc, mnC);
#pragma unroll
    for (int r = 0; r < 16; ++r) p0[r] = __builtin_amdgcn_exp2f(p0[r]);
}
__device__ __forceinline__ void finishSM(f32x16& p0, f32x16& p1, float alpha, float& l_reg, bf16x8& pa0, bf16x8& pa1, bf16x8& pa2, bf16x8& pa3) {
#pragma unroll
    for (int r = 0; r < 16; ++r) p1[r] = __builtin_amdgcn_exp2f(p1[r]);
    float ps = 0;
#pragma unroll
    for (int r = 0; r < 16; ++r) ps += p0[r];
#pragma unroll
    for (int r = 0; r < 16; ++r) ps += p1[r];
    { auto rr = __builtin_amdgcn_permlane32_swap(__float_as_uint(ps), __float_as_uint(ps), false, false);
      ps = __uint_as_float(rr[0]) + __uint_as_float(rr[1]); }
    l_reg = l_reg * alpha + ps;
#define PK4(P, BASE, OUT) do { unsigned a0 = cvt_pk_bf16(P[BASE + 0], P[BASE + 1]), a1 = cvt_pk_bf16(P[BASE + 2], P[BASE + 3]);   \
    unsigned b0 = cvt_pk_bf16(P[BASE + 4], P[BASE + 5]), b1 = cvt_pk_bf16(P[BASE + 6], P[BASE + 7]);                              \
    auto r0 = __builtin_amdgcn_permlane32_swap(a0, b0, false, false); auto r1 = __builtin_amdgcn_permlane32_swap(a1, b1, false, false); \
    u32x4 w = {r0[0], r1[0], r0[1], r1[1]}; OUT = *reinterpret_cast<bf16x8*>(&w); } while (0)
    PK4(p0, 0, pa0); PK4(p0, 8, pa1); PK4(p1, 0, pa2); PK4(p1, 8, pa3);
#undef PK4
}
#ifndef MLA_SD
#define MLA_SD 1
#endif
#ifndef MLA_NQL
#define MLA_NQL 4
#endif
template <int MLA>
__device__ __forceinline__ void qkt(f32x16& p0, f32x16& p1, const char* Ks, const char* Krs, const bf16x8* qr, const char* qrl, int r32, int hi) {
    constexpr int NQL = MLA ? MLA_NQL : 0;
    p0 = f32x16{}; p1 = f32x16{};
#pragma unroll
    for (int d0 = 0; d0 < 8; ++d0) { const int cb = (d0 * 16 + hi * 8) * 2;
        const bf16x8 b0 = *reinterpret_cast<const bf16x8*>(Ks + KSWZ(r32, cb));
        const bf16x8 b1 = *reinterpret_cast<const bf16x8*>(Ks + KSWZ(32 + r32, cb));
        bf16x8 qf; if (d0 < NQL) qf = *reinterpret_cast<const bf16x8*>(qrl + (4 + d0) * 1024); else qf = qr[d0 - NQL];
        p0 = __builtin_amdgcn_mfma_f32_32x32x16_bf16(b0, qf, p0, 0, 0, 0);
        p1 = __builtin_amdgcn_mfma_f32_32x32x16_bf16(b1, qf, p1, 0, 0, 0); }
    if constexpr (MLA) {
#pragma unroll
        for (int d0 = 0; d0 < 4; ++d0) { const int cb = (d0 * 16 + hi * 8) * 2;
            const bf16x8 b0 = *reinterpret_cast<const bf16x8*>(Krs + KRSWZ(r32, cb));
            const bf16x8 b1 = *reinterpret_cast<const bf16x8*>(Krs + KRSWZ(32 + r32, cb));
            const bf16x8 qf = *reinterpret_cast<const bf16x8*>(qrl + d0 * 1024);
            p0 = __builtin_amdgcn_mfma_f32_32x32x16_bf16(b0, qf, p0, 0, 0, 0);
            p1 = __builtin_amdgcn_mfma_f32_32x32x16_bf16(b1, qf, p1, 0, 0, 0); }
    }
}
__device__ __forceinline__ int v_st(int k, int c) { const int kk = (k & ~0xC) | ((k & 4) << 1) | ((k & 8) >> 1); return ((kk >> 3) * 4 + (c >> 5)) * 512 + ((kk & 7) * 32 + (c & 31)) * 2; }
__device__ __forceinline__ int v_rd_base(int lane) { return ((lane & 3) << 3) | (((lane >> 2) & 3) << 6) | (((lane >> 4) & 1) << 5) | (((lane >> 5) & 1) << 8); }
constexpr int v_rd_off(int d0, int ks, int half) { return d0 * 512 + ks * 4096 + half * 2048; }
template <int OFF> __device__ __forceinline__ s16x4 tr_read(int vb) {
    s16x4 r; asm volatile("ds_read_b64_tr_b16 %0, %1 offset:%2" : "=&v"(r) : "v"(vb), "i"(OFF) : "memory"); return r;
}
template <int D0> __device__ __forceinline__ void pv_one(f32x16& od, int vb, bf16x8 pa0, bf16x8 pa1, bf16x8 pa2, bf16x8 pa3) {
    const s16x4 l0 = tr_read<v_rd_off(D0, 0, 0)>(vb), h0 = tr_read<v_rd_off(D0, 0, 1)>(vb), l1 = tr_read<v_rd_off(D0, 1, 0)>(vb), h1 = tr_read<v_rd_off(D0, 1, 1)>(vb);
    const s16x4 l2 = tr_read<v_rd_off(D0, 2, 0)>(vb), h2 = tr_read<v_rd_off(D0, 2, 1)>(vb), l3 = tr_read<v_rd_off(D0, 3, 0)>(vb), h3 = tr_read<v_rd_off(D0, 3, 1)>(vb);
    asm volatile("s_waitcnt lgkmcnt(0)" ::: "memory"); SBAR();
#define PKV(L, H) (bf16x8){L[0], L[1], L[2], L[3], H[0], H[1], H[2], H[3]}
    od = __builtin_amdgcn_mfma_f32_32x32x16_bf16(PKV(l0, h0), pa0, od, 0, 0, 0);
    od = __builtin_amdgcn_mfma_f32_32x32x16_bf16(PKV(l1, h1), pa1, od, 0, 0, 0);
    od = __builtin_amdgcn_mfma_f32_32x32x16_bf16(PKV(l2, h2), pa2, od, 0, 0, 0);
    od = __builtin_amdgcn_mfma_f32_32x32x16_bf16(PKV(l3, h3), pa3, od, 0, 0, 0);
#undef PKV
}
__device__ __forceinline__ void pv_d0(f32x16* o, int vb, bf16x8 pa0, bf16x8 pa1, bf16x8 pa2, bf16x8 pa3) {
    pv_one<0>(o[0], vb, pa0, pa1, pa2, pa3); pv_one<1>(o[1], vb, pa0, pa1, pa2, pa3); pv_one<2>(o[2], vb, pa0, pa1, pa2, pa3); pv_one<3>(o[3], vb, pa0, pa1, pa2, pa3);
}

template <int MLA>
__device__ __forceinline__ void attn_unit(const bf16* __restrict__ Qn, const bf16* __restrict__ Qr, int ldq, const bf16* __restrict__ Kn, const bf16* __restrict__ Vn, int ldk,
                                          const bf16* __restrict__ Kr, bf16* __restrict__ O, int ldo, int seq, const float SCALE, char* lds) {
    constexpr int NQL = MLA ? MLA_NQL : 0, SD = MLA ? MLA_SD : 2;
    const int tid = threadIdx.x, wid = tid >> 6, lane = tid & 63, r32 = lane & 31, hi = lane >> 5;
    char* V_lds = lds + OFF_V; char* K_lds = lds + OFF_K; char* KR_lds = lds + OFF_KR;
    float m_reg = -1e30f, l_reg = 0; f32x16 o[4] = {}; bf16x8 qr[NQL < 8 ? 8 - NQL : 1];
    char* qrl = lds + OFF_QR + wid * 8192 + lane * 16;
    const bf16* Qw = Qn + (long)(wid * QBLK + r32) * ldq + hi * 8;
#pragma unroll
    for (int d0 = 0; d0 < 8; ++d0) { if (d0 < NQL) *(bf16x8*)(qrl + (4 + d0) * 1024) = ld8(Qw + d0 * 16); else qr[d0 - NQL] = ld8(Qw + d0 * 16); }
    if constexpr (MLA) { const bf16* Qx = Qr + (long)(wid * QBLK + r32) * ldq + hi * 8;
        *(bf16x8*)(qrl) = ld8(Qx); *(bf16x8*)(qrl + 1024) = ld8(Qx + 16); *(bf16x8*)(qrl + 2048) = ld8(Qx + 128); *(bf16x8*)(qrl + 3072) = ld8(Qx + 144); }
    const int sr = tid >> 4, sc = (tid & 15) * 8, vst0 = v_st(sr, sc), vst1 = v_st(32 + sr, sc);
    const int krr = tid >> 3, krc = (tid & 7) * 8;
    const int vb0 = (int)(uintptr_t)V_lds + v_rd_base(lane);
    struct { bf16x8 vs0, vs1, ks0, ks1, kr; } sr_[SD];
#define SLOAD(i, k0) do { sr_[i].vs0 = ld8(&Vn[(long)((k0) + sr) * ldk + sc]); sr_[i].vs1 = ld8(&Vn[(long)((k0) + 32 + sr) * ldk + sc]); \
    sr_[i].ks0 = ld8(&Kn[(long)((k0) + sr) * ldk + sc]); sr_[i].ks1 = ld8(&Kn[(long)((k0) + 32 + sr) * ldk + sc]); \
    if constexpr (MLA) sr_[i].kr = ld8(&Kr[(long)((k0) + krr) * 64 + krc]); } while (0)
#define SWRITE(b, i) do { *(bf16x8*)(V_lds + (b) * SHM_V + vst0) = sr_[i].vs0; *(bf16x8*)(V_lds + (b) * SHM_V + vst1) = sr_[i].vs1; { const int kc = sc * 2; \
    *(bf16x8*)(K_lds + (b) * SHM_K + KSWZ(sr, kc)) = sr_[i].ks0; *(bf16x8*)(K_lds + (b) * SHM_K + KSWZ(32 + sr, kc)) = sr_[i].ks1; } \
    if constexpr (MLA) *(bf16x8*)(KR_lds + (b) * SHM_KR + KRSWZ(krr, krc * 2)) = sr_[i].kr; } while (0)
#define SWAIT() do { if constexpr (SD == 1) asm volatile("s_waitcnt vmcnt(0)" ::: "memory"); else if constexpr (MLA) asm volatile("s_waitcnt vmcnt(5)" ::: "memory"); else asm volatile("s_waitcnt vmcnt(4)" ::: "memory"); } while (0)
#define RESC(a) do { if (__any((a) < 1.f)) { _Pragma("unroll") for (int d = 0; d < 4; ++d) _Pragma("unroll") for (int r = 0; r < 16; ++r) o[d][r] *= (a); } } while (0)
    f32x16 pA0, pA1, pB0, pB1; float mnA, mnB, alA, alB; bf16x8 pa0, pa1, pa2, pa3; const int NT = seq / KVBLK;
    constexpr int SE = 0, SO = SD - 1;
    SLOAD(SE, 0); asm volatile("s_waitcnt vmcnt(0)" ::: "memory"); SWRITE(0, SE); __syncthreads();
    qkt<MLA>(pA0, pA1, K_lds, KR_lds, qr, qrl, r32, hi); partialSM(pA0, pA1, m_reg, mnA, alA, SCALE);
    SLOAD(SO, KVBLK); if constexpr (SD == 2) { if (2 < NT) SLOAD(SE, 2 * KVBLK); }
    SWAIT(); SWRITE(1, SO); __syncthreads();
    for (int j = 1; j + 1 < NT; j += 2) {
        SBAR(); qkt<MLA>(pB0, pB1, K_lds + SHM_K, KR_lds + SHM_KR, qr, qrl, r32, hi);
        finishSM(pA0, pA1, alA, l_reg, pa0, pa1, pa2, pa3); SBAR();
        SLOAD(SO, (j + SD) * KVBLK); SBAR();
        pv_d0(o, vb0, pa0, pa1, pa2, pa3); partialSM(pB0, pB1, m_reg, mnB, alB, SCALE);
        __syncthreads(); SWAIT(); SWRITE(0, SE);
        RESC(alB); __syncthreads();
        SBAR(); qkt<MLA>(pA0, pA1, K_lds, KR_lds, qr, qrl, r32, hi);
        finishSM(pB0, pB1, alB, l_reg, pa0, pa1, pa2, pa3); SBAR();
        if (SD == 1 || j + 3 < NT) SLOAD(SE, (j + 1 + SD) * KVBLK); SBAR();
        pv_d0(o, vb0 + SHM_V, pa0, pa1, pa2, pa3); partialSM(pA0, pA1, m_reg, mnA, alA, SCALE);
        __syncthreads(); SWAIT(); SWRITE(1, SO);
        RESC(alA); __syncthreads();
    }
    SBAR(); qkt<MLA>(pB0, pB1, K_lds + SHM_K, KR_lds + SHM_KR, qr, qrl, r32, hi);
    finishSM(pA0, pA1, alA, l_reg, pa0, pa1, pa2, pa3); SBAR();
    pv_d0(o, vb0, pa0, pa1, pa2, pa3); partialSM(pB0, pB1, m_reg, mnB, alB, SCALE);
    __syncthreads(); RESC(alB);
    finishSM(pB0, pB1, alB, l_reg, pa0, pa1, pa2, pa3); SBAR();
    pv_d0(o, vb0 + SHM_V, pa0, pa1, pa2, pa3);
    const float rl = __builtin_amdgcn_rcpf(l_reg);
    bf16* Ow = O + (long)(wid * QBLK + r32) * ldo + 4 * hi;
#pragma unroll
    for (int d0 = 0; d0 < 4; ++d0)
#pragma unroll
        for (int g = 0; g < 4; ++g) { u32x2 w; w.x = cvt_pk_bf16(o[d0][4 * g] * rl, o[d0][4 * g + 1] * rl); w.y = cvt_pk_bf16(o[d0][4 * g + 2] * rl, o[d0][4 * g + 3] * rl);
            *(u32x2*)(Ow + 32 * d0 + 8 * g) = w; }
    __syncthreads();
#undef SLOAD
#undef SWRITE
#undef SWAIT
#undef RESC
}
}
static_assert(att::LDS_ATT <= RING_BYTES, "attention LDS");

__device__ __forceinline__ void p4_attn0(const Ctx& C) {
    const bf16* proj = (const bf16*)(C.ws + WS_PROJ); bf16* mix = (bf16*)(C.ws + WS_MIX);
    const float scale = 0.08838834764831845f;
    for (int u = C.vcu; u < 512 + 32; u += C.G) {
        int b, h, row0, seq;
        if (u < 512) { const int pair = u >> 6, w = u & 63; b = pair >> 1; h = (pair & 1) * 4 + (w >> 4); row0 = b * RPB + CL + 256 * (w & 15); seq = RPB; }
        else { const int v = u - 512; b = v >> 3; h = v & 7; row0 = b * RPB; seq = CL; }
        const int kvh = h >> 2; const bf16* kb = proj + (size_t)b * RPB * A_IN;
        att::attn_unit<0>(proj + (size_t)row0 * A_IN + 3072 + 128 * h, nullptr, A_IN, kb + 4096 + 128 * kvh, kb + 4352 + 128 * kvh, A_IN, nullptr,
                          mix + (size_t)row0 * DM + 1024 + 128 * h, DM, seq, scale, (char*)C.lds);
    }
}

template <int L>
__device__ __forceinline__ void p_mixer_ln(const Ctx& C, const Args& a) {
    const float* mod = (const float*)(C.ws + WS_MOD) + (size_t)L * 5 * 12288; float* X = (float*)(C.ws + WS_X);
    const bf16* y1 = (const bf16*)(C.ws + (L == 0 ? WS_Y1_0 : WS_Y1_1)); bf16* U = (bf16*)(C.ws + WS_U); bf16* ULO = (bf16*)(C.ws + WS_ULO);
    const float* lng = a.in[I_LNG] + (size_t)(L * 2 + 0) * DM; const float* lnb = a.in[I_LNB] + (size_t)(L * 2 + 0) * DM;
    for (int r = C.gw; r < MROWS; r += C.ngw) {
        int b, p; row_info(r, b, p); const bool isctx = p < CL; if (L == 1 && isctx) continue;
        const float* mr = mod + (size_t)(isctx ? 4 : b) * 12288;
        const float* xo = (L == 0) ? in_row(a, b, p) : X + (size_t)r * DM;
        f32x4 t[8]; float s = 0.f;
#pragma unroll
        for (int j = 0; j < 8; ++j) { const int e = 4 * (C.lane + 64 * j); const f32x4 x = *(const f32x4*)(xo + e), g = *(const f32x4*)(mr + 4096 + e); const u32x2 yw = *(const u32x2*)(y1 + (size_t)r * DM + e);
            const f32x4 y = {bf_lo(yw.x), bf_hi(yw.x), bf_lo(yw.y), bf_hi(yw.y)}; t[j] = x * DN_ALPHA + g * y; s += (t[j][0] + t[j][1]) + (t[j][2] + t[j][3]); }
        const float mean = wave_sum(s) * (1.f / DM); float s2 = 0.f;
#pragma unroll
        for (int j = 0; j < 8; ++j) { t[j] = t[j] - mean; s2 += (t[j][0] * t[j][0] + t[j][1] * t[j][1]) + (t[j][2] * t[j][2] + t[j][3] * t[j][3]); }
        const float rstd = 1.f / sqrtf(wave_sum(s2) * (1.f / DM) + LN_EPS);
#pragma unroll
        for (int j = 0; j < 8; ++j) { const int e = 4 * (C.lane + 64 * j); const f32x4 xn = t[j] * rstd * *(const f32x4*)(lng + e) + *(const f32x4*)(lnb + e);
            *(f32x4*)(X + (size_t)r * DM + e) = xn;
            const f32x4 v = xn * (*(const f32x4*)(mr + 8192 + e) + 1.f) + *(const f32x4*)(mr + 6144 + e);
            u32x2 w; w.x = cvt_pk_bf16(v[0], v[1]); w.y = cvt_pk_bf16(v[2], v[3]); *(u32x2*)(U + (size_t)r * DM + e) = w;
            u32x2 l; l.x = cvt_pk_bf16(v[0] - bf_lo(w.x), v[1] - bf_hi(w.x)); l.y = cvt_pk_bf16(v[2] - bf_lo(w.y), v[3] - bf_hi(w.y)); *(u32x2*)(ULO + (size_t)r * DM + e) = l; }
    }
}

struct EpiLogits {
    float* O;
    __device__ __forceinline__ void operator()(const f32x4 (&acc)[2][2][4][2], const pg8::Unit& u, int wr, int wc, int fr, int fq) const {
        const int row0 = u.pm * 256 + wr * 64 + fr, col0 = wc * 32 + 8 * fq;
#pragma unroll
        for (int ai = 0; ai < 2; ++ai)
#pragma unroll
            for (int m = 0; m < 4; ++m) { float* rowp = O + (size_t)(row0 + ai * 128 + m * 16) * 128 + col0;
                *(f32x4*)(rowp) = acc[ai][0][m][0]; *(f32x4*)(rowp + 4) = acc[ai][0][m][1]; }
    }
};

template <int L>
__device__ __forceinline__ void p_route(const Ctx& C, const Args& a) {
    const float* LOG = (const float*)(C.ws + WS_LOG); int* TE = (int*)(C.ws + WS_TE); float* TW = (float*)(C.ws + WS_TW); int* INV = (int*)(C.ws + WS_INV);
    LAS int* hist = (LAS int*)C.lds; LAS int* base = hist + 64; LAS int* rec = hist + 128;
    if (C.tid < 128) hist[C.tid] = 0;
    __syncthreads();
    const float rb = a.in[I_RB][L * NE + C.lane];
    const float NINF = -__builtin_inff();
    int it = 0;
    for (int r = C.gw; r < MROWS; r += C.ngw, ++it) {
        int b, p; row_info(r, b, p); if (L == 1 && p < CL) continue;
        const float lg = (LOG[(size_t)r * 128 + C.lane] + LOG[(size_t)r * 128 + 64 + C.lane]) + (LOG[(size_t)(MROWS + r) * 128 + C.lane] + LOG[(size_t)(MROWS + r) * 128 + 64 + C.lane]);
        const float sc = 1.f / (1.f + __expf(-lg));
        const float sel = sc + rb;
        float m1 = sel; m1 = fmaxf(m1, __shfl_xor(m1, 1)); m1 = fmaxf(m1, __shfl_xor(m1, 2)); m1 = fmaxf(m1, __shfl_xor(m1, 4));
        const unsigned long long eq = __ballot(sel == m1); const int g = C.lane >> 3;
        const unsigned gm = (unsigned)(eq >> (8 * g)) & 0xFFu; const int first = 8 * g + (__ffs(gm) - 1);
        float m2 = (C.lane == first) ? NINF : sel; m2 = fmaxf(m2, __shfl_xor(m2, 1)); m2 = fmaxf(m2, __shfl_xor(m2, 2)); m2 = fmaxf(m2, __shfl_xor(m2, 4));
        const float gs = m1 + m2;
        int grank = 0;
#pragma unroll
        for (int q = 0; q < 8; ++q) { const float o = __shfl(gs, 8 * q); grank += (o > gs || (o == gs && q < g)) ? 1 : 0; }
        const bool gsel = grank < 4;
        const float ms = gsel ? sel : NINF;
        int rank = 0;
#pragma unroll
        for (int q = 0; q < 64; ++q) { const float o = __shfl(ms, q); rank += (o > ms || (o == ms && q < C.lane)) ? 1 : 0; }
        const bool chosen = gsel && rank < 6;
        const float wsum = wave_sum(chosen ? sc : 0.f);
        if (chosen) {
            const int lr = atomicAdd((int*)&hist[C.lane], 1);
            rec[((C.wave * 12 + it) * 8 + rank) * 2] = C.lane; rec[((C.wave * 12 + it) * 8 + rank) * 2 + 1] = lr;
            TW[(size_t)r * 8 + rank] = sc / wsum * 2.5f;
        }
    }
    __syncthreads();
    if (C.tid < 64) { const int h = hist[C.tid]; base[C.tid] = h ? (int)__hip_atomic_fetch_add(C.ctl + CW_CNT + L * 64 + C.tid, (unsigned)h, RLX_AGENT) : 0; }
    __syncthreads();
    it = 0;
    for (int r = C.gw; r < MROWS; r += C.ngw, ++it) {
        int b, p; row_info(r, b, p); if (L == 1 && p < CL) continue;
        if (C.lane < 6) { const int e = rec[((C.wave * 12 + it) * 8 + C.lane) * 2], lr = rec[((C.wave * 12 + it) * 8 + C.lane) * 2 + 1];
            TE[(size_t)r * 8 + C.lane] = e; INV[(size_t)r * 8 + C.lane] = lr + base[e]; }
    }
    __syncthreads();
}

template <int L>
__device__ __forceinline__ void p_dispatch(const Ctx& C) {
    const int* TE = (const int*)(C.ws + WS_TE); int* INV = (int*)(C.ws + WS_INV); int* BLKE = (int*)(C.ws + WS_BLKE);
    const bf16* U = (const bf16*)(C.ws + WS_U); bf16* XS = (bf16*)(C.ws + WS_XS);
    LAS int* pstart = (LAS int*)C.lds;
    if (C.tid == 0) { int acc = 0; for (int e = 0; e < NE; ++e) { const int c = (int)__hip_atomic_load(C.ctl + CW_CNT + L * 64 + e, RLX_AGENT); pstart[e] = acc; const int nb = (c + 255) >> 8;
            if (C.bid == 0) for (int q = 0; q < nb; ++q) BLKE[(acc >> 8) + q] = e;
            acc += nb << 8; }
        pstart[NE] = acc; if (C.bid == 0) C.ctl[CW_NBLK + L] = (unsigned)(acc >> 8); }
    __syncthreads();
    for (int r = C.gw; r < MROWS; r += C.ngw) {
        int b, p; row_info(r, b, p); if (L == 1 && p < CL) continue;
        int slot = 0;
        if (C.lane < 6) { const int e = TE[(size_t)r * 8 + C.lane]; slot = pstart[e] + INV[(size_t)r * 8 + C.lane]; INV[(size_t)r * 8 + C.lane] = slot; }
        u32x4 v[4];
#pragma unroll
        for (int j = 0; j < 4; ++j) v[j] = *(const u32x4*)(U + (size_t)r * DM + 8 * (C.lane + 64 * j));
#pragma unroll
        for (int k = 0; k < 6; ++k) { const int s = __shfl(slot, k);
#pragma unroll
            for (int j = 0; j < 4; ++j) *(u32x4*)(XS + (size_t)s * DM + 8 * (C.lane + 64 * j)) = v[j]; }
    }
    __syncthreads();
}

__device__ __forceinline__ int nblk_ld(const Ctx& C, int L) { const int n = (int)__hip_atomic_load(C.ctl + CW_NBLK + L, RLX_AGENT); return n < XS_BLK ? n : XS_BLK; }
struct MoeSched {
    const int* blke; int nblk_r, nsh, ncol, G, c, sh_lat_only;
    __device__ __forceinline__ bool next(int i, pg8::Unit& u) const {
        const int total = (nblk_r + nsh) * ncol; const long Lq = (long)i * G + c; if (Lq >= total) return false;
        const int w = pg8::xcd_remap((int)Lq, total); const int b = w / ncol, j = w - b * ncol;
        int e, pm;
        if (b < nblk_r) { pm = b; e = (int)__hip_atomic_load((const unsigned*)blke + b, RLX_AGENT) & 63; } else { int sb = b - nblk_r; if (sh_lat_only) sb = 17 * (sb >> 4) + 1 + (sb & 15); pm = XS_BLK + sb; e = NE; }
        u.pm = pm; u.pn = e * ncol + j; return true;
    }
};
struct EpiSwiGLU {
    bf16* H;
    __device__ __forceinline__ void operator()(const f32x4 (&acc)[2][2][4][2], const pg8::Unit& u, int wr, int wc, int fr, int fq) const {
        const int row0 = u.pm * 256 + wr * 64 + fr, col0 = (u.pn & 3) * 128 + wc * 32 + 8 * fq;
#pragma unroll
        for (int ai = 0; ai < 2; ++ai)
#pragma unroll
            for (int m = 0; m < 4; ++m) { float h[8];
#pragma unroll
                for (int n = 0; n < 2; ++n)
#pragma unroll
                    for (int i = 0; i < 4; ++i) { const float g = acc[ai][0][m][n][i], up = acc[ai][1][m][n][i]; h[4 * n + i] = g * __builtin_amdgcn_rcpf(1.f + __expf(-g)) * up; }
                u32x4 w; w.x = cvt_pk_bf16(h[0], h[1]); w.y = cvt_pk_bf16(h[2], h[3]); w.z = cvt_pk_bf16(h[4], h[5]); w.w = cvt_pk_bf16(h[6], h[7]);
                *(u32x4*)(H + (size_t)(row0 + ai * 128 + m * 16) * FF + col0) = w; }
    }
};
struct EpiDown {
    bf16* Y;
    __device__ __forceinline__ void operator()(const f32x4 (&acc)[2][2][4][2], const pg8::Unit& u, int wr, int wc, int fr, int fq) const {
        const int row0 = u.pm * 256 + wr * 64 + fr, col0 = (u.pn & 7) * 256 + wc * 32 + 8 * fq;
#pragma unroll
        for (int ai = 0; ai < 2; ++ai)
#pragma unroll
            for (int m = 0; m < 4; ++m) { bf16* rowp = Y + (size_t)(row0 + ai * 128 + m * 16) * DM + col0;
#pragma unroll
                for (int bj = 0; bj < 2; ++bj) { const f32x4 v0 = acc[ai][bj][m][0], v1 = acc[ai][bj][m][1];
                    u32x4 w; w.x = cvt_pk_bf16(v0[0], v0[1]); w.y = cvt_pk_bf16(v0[2], v0[3]); w.z = cvt_pk_bf16(v1[0], v1[1]); w.w = cvt_pk_bf16(v1[2], v1[3]);
                    *(u32x4*)(rowp + bj * 128) = w; } }
    }
};

template <int L>
__device__ __forceinline__ void p_combine(const Ctx& C, const Args& a) {
    const float* mod = (const float*)(C.ws + WS_MOD) + (size_t)L * 5 * 12288; float* X = (float*)(C.ws + WS_X);
    const bf16* Y = (const bf16*)(C.ws + WS_Y); const int* INV = (const int*)(C.ws + WS_INV); const float* TW = (const float*)(C.ws + WS_TW);
    bf16* UM = (bf16*)(C.ws + WS_UM);
    const float* lng = a.in[I_LNG] + (size_t)(L * 2 + 1) * DM; const float* lnb = a.in[I_LNB] + (size_t)(L * 2 + 1) * DM;
    for (int r = C.gw; r < MROWS; r += C.ngw) {
        int b, p; row_info(r, b, p); const bool isctx = p < CL; if (L == 1 && isctx) continue;
        const float* mr = mod + (size_t)(isctx ? 4 : b) * 12288;
        int slot = 0; float wt = 0.f;
        if (C.lane < 6) { slot = INV[(size_t)r * 8 + C.lane]; wt = TW[(size_t)r * 8 + C.lane]; }
        f32x4 f[8];
        { const bf16* ys = Y + ((size_t)XS_BLK * 256 + r) * DM;
#pragma unroll
          for (int j = 0; j < 8; ++j) { const u32x2 yw = *(const u32x2*)(ys + 4 * (C.lane + 64 * j)); f[j] = (f32x4){bf_lo(yw.x), bf_hi(yw.x), bf_lo(yw.y), bf_hi(yw.y)}; } }
#pragma unroll
        for (int k = 0; k < 6; ++k) { const int s = __shfl(slot, k); const float w = __shfl(wt, k); const bf16* ys = Y + (size_t)s * DM;
#pragma unroll
            for (int j = 0; j < 8; ++j) { const u32x2 yw = *(const u32x2*)(ys + 4 * (C.lane + 64 * j)); f[j] += (f32x4){bf_lo(yw.x), bf_hi(yw.x), bf_lo(yw.y), bf_hi(yw.y)} * w; } }
        float s = 0.f;
#pragma unroll
        for (int j = 0; j < 8; ++j) { const int e = 4 * (C.lane + 64 * j); f[j] = *(const f32x4*)(X + (size_t)r * DM + e) * DN_ALPHA + *(const f32x4*)(mr + 10240 + e) * f[j]; s += (f[j][0] + f[j][1]) + (f[j][2] + f[j][3]); }
        const float mean = wave_sum(s) * (1.f / DM); float s2 = 0.f;
#pragma unroll
        for (int j = 0; j < 8; ++j) { f[j] = f[j] - mean; s2 += (f[j][0] * f[j][0] + f[j][1] * f[j][1]) + (f[j][2] * f[j][2] + f[j][3] * f[j][3]); }
        const float rstd = 1.f / sqrtf(wave_sum(s2) * (1.f / DM) + LN_EPS);
        float* orow = (L == 0) ? X + (size_t)r * DM : a.out + ((size_t)(b * SEQ + (p - CL))) * DM;
        const float* mn = mod + (size_t)5 * 12288 + (size_t)(isctx ? 4 : b) * 12288;
#pragma unroll
        for (int j = 0; j < 8; ++j) { const int e = 4 * (C.lane + 64 * j); const f32x4 xn = f[j] * rstd * *(const f32x4*)(lng + e) + *(const f32x4*)(lnb + e);
            *(f32x4*)(orow + e) = xn;
            if (L == 0) { const f32x4 v = xn * (*(const f32x4*)(mn + 2048 + e) + 1.f) + *(const f32x4*)(mn + e);
                u32x2 w; w.x = cvt_pk_bf16(v[0], v[1]); w.y = cvt_pk_bf16(v[2], v[3]); *(u32x2*)(UM + (size_t)r * DM + e) = w; } }
    }
}

__device__ __forceinline__ void p13_mla_norm(const Ctx& C, const Args& a) {
    const bf16* dp = (const bf16*)(C.ws + WS_DOWNP); bf16* cq = (bf16*)(C.ws + WS_CQKV); bf16* ckv = cq + (size_t)MROWS * 512; bf16* kr = (bf16*)(C.ws + WS_KR);
    const f32x2* rope = (const f32x2*)(C.ws + WS_ROPE64);
    const f32x4 qga = *(const f32x4*)(a.in[I_MQG] + 8 * C.lane), qgb = *(const f32x4*)(a.in[I_MQG] + 8 * C.lane + 4);
    const f32x4 kga = *(const f32x4*)(a.in[I_MKVG] + 8 * C.lane), kgb = *(const f32x4*)(a.in[I_MKVG] + 8 * C.lane + 4);
    for (int r = C.gw; r < MROWS; r += C.ngw) {
        int b, p; row_info(r, b, p); const bool isctx = p < CL;
        const bf16* row = dp + (size_t)r * 1280;
#pragma unroll
        for (int part = 0; part < 2; ++part) {
            const u32x4 w = *(const u32x4*)(row + 512 * part + 8 * C.lane);
            float v[8] = {bf_lo(w.x), bf_hi(w.x), bf_lo(w.y), bf_hi(w.y), bf_lo(w.z), bf_hi(w.z), bf_lo(w.w), bf_hi(w.w)};
            float ss = 0.f;
#pragma unroll
            for (int q = 0; q < 8; ++q) ss += v[q] * v[q];
            const float rs = 1.f / sqrtf(wave_sum(ss) * (1.f / 512.f) + RMS_EPS);
            const f32x4 ga = part ? kga : qga, gb = part ? kgb : qgb;
            u32x4 o; o.x = cvt_pk_bf16(v[0] * rs * ga[0], v[1] * rs * ga[1]); o.y = cvt_pk_bf16(v[2] * rs * ga[2], v[3] * rs * ga[3]);
            o.z = cvt_pk_bf16(v[4] * rs * gb[0], v[5] * rs * gb[1]); o.w = cvt_pk_bf16(v[6] * rs * gb[2], v[7] * rs * gb[3]);
            *(u32x4*)((part ? ckv : cq) + (size_t)r * 512 + 8 * C.lane) = o;
        }
        if (C.lane < 32) { const float x1 = bf2f(row[1024 + C.lane]), x2 = bf2f(row[1056 + C.lane]);
            f32x2 cs = {1.f, 0.f}; if (!isctx) cs = rope[(size_t)(p - CL) * 32 + C.lane];
            kr[(size_t)r * 64 + C.lane] = (bf16)f2bf(x1 * cs.x - x2 * cs.y); kr[(size_t)r * 64 + 32 + C.lane] = (bf16)f2bf(x2 * cs.x + x1 * cs.y); }
    }
}

struct UpSched {
    int G, c;
    __device__ __forceinline__ bool next(int i, pg8::Unit& u) const {
        constexpr int NQ = 64 * 12, NKV = MT * 16; const long Lq = (long)i * G + c; if (Lq >= NQ + NKV) return false;
        const int w = pg8::xcd_remap((int)Lq, NQ + NKV); int pm, pn;
        if (w < NQ) { pg8::tile_of(w, 64, 12, pm, pn); pm = 17 * (pm >> 4) + 1 + (pm & 15); }
        else { pg8::tile_of(w - NQ, MT, 16, pm, pn); pm += MT; pn += 12; }
        u.pm = pm; u.pn = pn; return true;
    }
};
struct EpiUp {
    bf16* QB; bf16* KVB; const f32x2* rope;
    __device__ __forceinline__ void operator()(const f32x4 (&acc)[2][2][4][2], const pg8::Unit& u, int wr, int wc, int fr, int fq) const {
        const bool isq = u.pn < 12; const int rowt = isq ? u.pm : u.pm - MT;
        const int row0 = rowt * 256 + wr * 64 + fr, cw = wc * 32 + 8 * fq;
        bf16* base = isq ? QB + 256 * u.pn + cw : KVB + 256 * (u.pn - 12) + cw; const int ldc = isq ? 3072 : 4096;
        const bool dorope = isq && u.pn >= 8;
#pragma unroll
        for (int ai = 0; ai < 2; ++ai)
#pragma unroll
            for (int m = 0; m < 4; ++m) { const int row = row0 + ai * 128 + m * 16; bf16* rowp = base + (size_t)row * ldc;
                f32x4 a0 = acc[ai][0][m][0], a1 = acc[ai][0][m][1], b0 = acc[ai][1][m][0], b1 = acc[ai][1][m][1];
                if (dorope) { const int bb = row / RPB, pos = row - bb * RPB - CL; const f32x2* rp = rope + (size_t)pos * 32 + 8 * fq;
#pragma unroll
                    for (int i = 0; i < 4; ++i) { const f32x2 c0 = rp[i], c1 = rp[4 + i];
                        const float x1 = a0[i], x2 = b0[i]; a0[i] = x1 * c0.x - x2 * c0.y; b0[i] = x2 * c0.x + x1 * c0.y;
                        const float y1 = a1[i], y2 = b1[i]; a1[i] = y1 * c1.x - y2 * c1.y; b1[i] = y2 * c1.x + y1 * c1.y; } }
                u32x4 w; w.x = cvt_pk_bf16(a0[0], a0[1]); w.y = cvt_pk_bf16(a0[2], a0[3]); w.z = cvt_pk_bf16(a1[0], a1[1]); w.w = cvt_pk_bf16(a1[2], a1[3]);
                *(u32x4*)(rowp) = w;
                w.x = cvt_pk_bf16(b0[0], b0[1]); w.y = cvt_pk_bf16(b0[2], b0[3]); w.z = cvt_pk_bf16(b1[0], b1[1]); w.w = cvt_pk_bf16(b1[2], b1[3]);
                *(u32x4*)(rowp + 128) = w; }
    }
};

__device__ __forceinline__ void p15_attn1(const Ctx& C) {
    const bf16* qb = (const bf16*)(C.ws + WS_QB); const bf16* kvb = (const bf16*)(C.ws + WS_KVB); const bf16* kr = (const bf16*)(C.ws + WS_KR); bf16* attb = (bf16*)(C.ws + WS_ATT);
    const float scale = 0.07216878364870323f;
    for (int u = C.vcu; u < 1024; u += C.G) {
        const int bh = u >> 4, qblk = u & 15, b = bh >> 4, h = bh & 15, row0 = b * RPB + CL + 256 * qblk;
        const bf16* kn = kvb + (size_t)b * RPB * 4096 + 256 * h;
        att::attn_unit<1>(qb + (size_t)row0 * 3072 + 128 * h, qb + (size_t)row0 * 3072 + 2048 + 256 * (h >> 2) + 32 * (h & 3), 3072, kn, kn + 128, 4096, kr + (size_t)b * RPB * 64,
                          attb + (size_t)row0 * DM + 128 * h, DM, RPB, scale, (char*)C.lds);
    }
}

constexpr int NPH = 24;
__global__ void __launch_bounds__(512, 2) fwd(Args args) {
    extern __shared__ __attribute__((aligned(16))) unsigned char lds_raw[];
    Ctx C;
    C.lds = (LAS unsigned char*)lds_raw;
    C.tid = threadIdx.x; C.lane = C.tid & 63; C.wave = __builtin_amdgcn_readfirstlane(C.tid >> 6);
    C.G = gridDim.x; C.bid = blockIdx.x; C.vcu = (C.G % 8 == 0) ? (C.bid % 8) * (C.G / 8) + C.bid / 8 : C.bid;
    C.gw = C.bid * 8 + C.wave; C.ngw = C.G * 8;
    C.ws = args.ws; C.ctl = (unsigned*)(args.ws + WS_CTL);
    volatile LAS unsigned* MISC = (volatile LAS unsigned*)(C.lds + MISC_OFF);
    for (int u = C.tid; u < (LDS_BYTES - RING_BYTES) / 4; u += 512) ((LAS unsigned*)(C.lds + RING_BYTES))[u] = 0u;
    __syncthreads();
    XcdBarrier bar; bar.bar = C.ctl + CW_BAR; bar.x = 0; bar.st = nullptr;
    if (!MK_PER_PHASE) bar = xcd_barrier_post(C.ctl + CW_BAR, MISC + 8);
    const int lo = args.ph_lo, hi = args.ph_hi;
    unsigned char* ws = C.ws;
#ifndef PHMASK
#define PHMASK 0xFFFFFFFFu
#endif
#define IN(k) (((PHMASK >> (k)) & 1u) && lo <= (k) && (k) < hi)
#define SEAM(k) do { if (IN(k) && IN((k) + 1)) xcd_barrier(bar); } while (0)

    if (IN(0)) p0_prologue(C, args);
    SEAM(0);
    if (IN(1)) p1_modulate0(C, args);
    SEAM(1);
    if (IN(2)) {
        pg8::Gemm g{(const bf16*)(ws + WS_UM), (const bf16*)(ws + WS_W_IN), DM}; DenseSched S{MT, A_IN / 256, C.G, C.bid, 0, 0, 0};
        EpiStoreBf16 E{(bf16*)(ws + WS_PROJ), A_IN}; pg8::gemm_phase(C.lds, g, S, E);
    }
    SEAM(2);
    if (IN(3)) p3_qk_conv(C, args);
    SEAM(3);
    if (IN(4)) p4_attn0(C);
    SEAM(4);
    if (IN(5)) {
        pg8::Gemm g{(const bf16*)(ws + WS_MIX), (const bf16*)(ws + WS_W_OUT0), DM}; DenseSched S{MT, DM / 256, C.G, C.bid, 0, 0, 0};
        EpiStoreBf16 E{(bf16*)(ws + WS_Y1_0), DM}; pg8::gemm_phase(C.lds, g, S, E);
    }
    SEAM(5);
    if (IN(6)) p_mixer_ln<0>(C, args);
    SEAM(6);
    if (IN(7)) {
        pg8::Gemm g{(const bf16*)(ws + WS_U), (const bf16*)(ws + WS_W_RT), DM}; DenseSched S{2 * MT, 1, C.G, C.bid, 0, 0, 0};
        EpiLogits E{(float*)(ws + WS_LOG)}; pg8::gemm_phase(C.lds, g, S, E);
    }
    SEAM(7);
    if (IN(8)) p_route<0>(C, args);
    SEAM(8);
    if (IN(9)) p_dispatch<0>(C);
    SEAM(9);
    if (IN(10)) {
        pg8::Gemm g{(const bf16*)(ws + WS_XS), (const bf16*)(ws + WS_W_GU), DM};
        MoeSched S{(const int*)(ws + WS_BLKE), nblk_ld(C, 0), SH_BLK, 4, C.G, C.bid, 0};
        EpiSwiGLU E{(bf16*)(ws + WS_H)}; pg8::gemm_phase(C.lds, g, S, E);
    }
    SEAM(10);
    if (IN(11)) {
        pg8::Gemm g{(const bf16*)(ws + WS_H), (const bf16*)(ws + WS_W_D), FF};
        MoeSched S{(const int*)(ws + WS_BLKE), nblk_ld(C, 0), SH_BLK, 8, C.G, C.bid, 0};
        EpiDown E{(bf16*)(ws + WS_Y)}; pg8::gemm_phase(C.lds, g, S, E);
    }
    SEAM(11);
    if (IN(12)) p_combine<0>(C, args);
    SEAM(12);
    if (IN(13)) {
        pg8::Gemm g{(const bf16*)(ws + WS_UM), (const bf16*)(ws + WS_W_DOWN), DM}; DenseSched S{MT, 5, C.G, C.bid, 0, 0, 0};
        EpiStoreBf16 E{(bf16*)(ws + WS_DOWNP), 1280}; pg8::gemm_phase(C.lds, g, S, E);
    }
    SEAM(13);
    if (IN(14)) p13_mla_norm(C, args);
    SEAM(14);
    if (IN(15)) {
        pg8::Gemm g{(const bf16*)(ws + WS_CQKV), (const bf16*)(ws + WS_W_UQKV), 512}; UpSched S{C.G, C.bid};
        EpiUp E{(bf16*)(ws + WS_QB), (bf16*)(ws + WS_KVB), (const f32x2*)(ws + WS_ROPE64)}; pg8::gemm_phase(C.lds, g, S, E);
    }
    SEAM(15);
    if (IN(16)) p15_attn1(C);
    SEAM(16);
    if (IN(17)) {
        pg8::Gemm g{(const bf16*)(ws + WS_ATT), (const bf16*)(ws + WS_W_OUT1), DM}; DenseSched S{64, DM / 256, C.G, C.bid, 1, 0, 0};
        EpiStoreBf16 E{(bf16*)(ws + WS_Y1_1), DM}; pg8::gemm_phase(C.lds, g, S, E);
    }
    SEAM(17);
    if (IN(18)) p_mixer_ln<1>(C, args);
    SEAM(18);
    if (IN(19)) {
        pg8::Gemm g{(const bf16*)(ws + WS_U), (const bf16*)(ws + WS_W_RT + (size_t)256 * DM * 2), DM}; DenseSched S{2 * MT, 1, C.G, C.bid, 0, 0, 0};
        EpiLogits E{(float*)(ws + WS_LOG)}; pg8::gemm_phase(C.lds, g, S, E);
    }
    SEAM(19);
    if (IN(20)) p_route<1>(C, args);
    SEAM(20);
    if (IN(21)) p_dispatch<1>(C);
    SEAM(21);
    if (IN(22)) {
        pg8::Gemm g{(const bf16*)(ws + WS_XS), (const bf16*)(ws + WS_W_GU) + W_GU_L, DM};
        MoeSched S{(const int*)(ws + WS_BLKE), nblk_ld(C, 1), 64, 4, C.G, C.bid, 1};
        EpiSwiGLU E{(bf16*)(ws + WS_H)}; pg8::gemm_phase(C.lds, g, S, E);
    }
    SEAM(22);
    if (IN(23)) {
        pg8::Gemm g{(const bf16*)(ws + WS_H), (const bf16*)(ws + WS_W_D) + W_D_L, FF};
        MoeSched S{(const int*)(ws + WS_BLKE), nblk_ld(C, 1), 64, 8, C.G, C.bid, 1};
        EpiDown E{(bf16*)(ws + WS_Y)}; pg8::gemm_phase(C.lds, g, S, E);
    }
    SEAM(23);
    if (IN(24)) p_combine<1>(C, args);
#undef IN
#undef SEAM
}

extern "C" void kernel_launch(void* const* d_in, const int* in_sizes, int n_in, void* d_out, int out_size, void* d_ws, size_t ws_size, hipStream_t stream) {
    static int grid = 0;
    if (grid == 0) {
        if (n_in != 27 || ws_size < WS_END) { fprintf(stderr, "kernel_launch: n_in %d ws %zu (need %zu)\n", n_in, ws_size, (size_t)WS_END); grid = -1; return; }
        int dev = 0, cus = 0, per_cu = 0;
        if (hipGetDevice(&dev) != hipSuccess || hipDeviceGetAttribute(&cus, hipDeviceAttributeMultiprocessorCount, dev) != hipSuccess) { grid = -1; return; }
        if (hipFuncSetAttribute((const void*)fwd, hipFuncAttributeMaxDynamicSharedMemorySize, LDS_BYTES) != hipSuccess) { fprintf(stderr, "kernel_launch: hipFuncSetAttribute failed\n"); grid = -1; return; }
        if (hipOccupancyMaxActiveBlocksPerMultiprocessor(&per_cu, (const void*)fwd, 512, LDS_BYTES) != hipSuccess || per_cu < 1) fprintf(stderr, "kernel_launch: occupancy query says %d\n", per_cu);
        (void)hipGetLastError();
        grid = cus;
    }
    if (grid < 0) return;
    if (hipMemsetAsync((char*)d_ws + WS_CTL, 0, CTL_ZERO_BYTES, stream) != hipSuccess) return;
    Args a{};
    for (int i = 0; i < 27; ++i) a.in[i] = (const float*)d_in[i];
    a.out = (float*)d_out; a.ws = (unsigned char*)d_ws;
#if MK_PER_PHASE
    for (int k = 0; k <= NPH; ++k) { a.ph_lo = k; a.ph_hi = k + 1; hipLaunchKernelGGL(fwd, dim3(grid), dim3(512), LDS_BYTES, stream, a); }
#else
    a.ph_lo = 0; a.ph_hi = NPH + 1;
    hipLaunchKernelGGL(fwd, dim3(grid), dim3(512), LDS_BYTES, stream, a);
#endif
    const hipError_t le = hipPeekAtLastError();
    if (le != hipSuccess) fprintf(stderr, "kernel_launch: launch failed: %s\n", hipGetErrorName(le));
}
```

```cpp
#include <hip/hip_runtime.h>
#include <cstdio>
#include <cstdint>

#ifndef MK_PER_PHASE
#define MK_PER_PHASE 0
#endif

#define GAS __attribute__((address_space(1)))
#define LAS __attribute__((address_space(3)))
typedef unsigned short bf16;
typedef short bf16x8 __attribute__((ext_vector_type(8)));
typedef short s16x4 __attribute__((ext_vector_type(4)));
typedef float f32x4 __attribute__((ext_vector_type(4)));
typedef float f32x2 __attribute__((ext_vector_type(2)));
typedef float f32x16 __attribute__((ext_vector_type(16)));
typedef unsigned u32x4 __attribute__((ext_vector_type(4)));
typedef unsigned u32x2 __attribute__((ext_vector_type(2)));
#define RLX_AGENT __ATOMIC_RELAXED, __HIP_MEMORY_SCOPE_AGENT
#define LDS_WAIT() asm volatile("s_waitcnt lgkmcnt(0)" ::: "memory")
#define SBAR() __builtin_amdgcn_sched_barrier(0)

__device__ __forceinline__ unsigned cvt_pk_bf16(float lo, float hi) { unsigned r; asm volatile("v_cvt_pk_bf16_f32 %0, %1, %2" : "=v"(r) : "v"(lo), "v"(hi)); return r; }
__device__ __forceinline__ float bf_lo(unsigned w) { return __uint_as_float(w << 16); }
__device__ __forceinline__ float bf_hi(unsigned w) { return __uint_as_float(w & 0xffff0000u); }
__device__ __forceinline__ float bf2f(bf16 v) { return __uint_as_float(((unsigned)v) << 16); }
__device__ __forceinline__ unsigned f2bf(float f) { unsigned u = __float_as_uint(f); return (u + 0x7fffu + ((u >> 16) & 1u)) >> 16; }
__device__ __forceinline__ float wave_sum(float v) {
#pragma unroll
    for (int o = 1; o < 64; o <<= 1) v += __shfl_xor(v, o);
    return v;
}

namespace pg8 {
constexpr int BM = 256, BK = 64, HALF = 128, HTB = HALF * BK * 2, STAGE_BYTES = 8 * HTB, NXCD = 8, WGM = 8;
__host__ __device__ __forceinline__ int lds_byte(int r, int c) { const int st = (r >> 4) * 2 + (c >> 5), rr = r & 15, cc = c & 31, ob = rr * 64 + cc * 2; return st * 1024 + (ob ^ (((ob >> 9) & 1) << 5)); }
__host__ __device__ __forceinline__ void stage_rc(int b, int& R, int& C) { const int st = b / 1024, sb = b % 1024, swz = sb ^ (((sb >> 9) & 1) << 5); R = (st >> 1) * 16 + swz / 64; C = (st & 1) * 32 + (swz % 64) / 2; }
__host__ __device__ __forceinline__ int perm32(int rho) { const int n = rho >> 4, i = rho & 15; return 8 * (i >> 2) + 4 * n + (i & 3); }

struct Unit { int pm, pn; };
struct Gemm { const bf16* A; const bf16* Bt; int K; };

__device__ __forceinline__ int xcd_remap(int wgid, int nwg) { const int q = nwg / NXCD, r = nwg % NXCD, xcd = wgid % NXCD, off = wgid / NXCD; return (xcd < r ? xcd * (q + 1) : r * (q + 1) + (xcd - r) * q) + off; }
__device__ __forceinline__ void tile_of(int wgid, int nM, int nN, int& pm, int& pn) {
    const int nig = WGM * nN, gid = wgid / nig, fm = gid * WGM, gsz = (nM - fm) < WGM ? (nM - fm) : WGM;
    pm = fm + ((wgid % nig) % gsz); pn = (wgid % nig) / gsz;
}

template <class Epi, class Sched, bool ALIGN_EPI = true, bool SP2 = true>
__device__ __forceinline__ void gemm_phase(LAS unsigned char* lds, const Gemm g, const Sched& S, const Epi& E) {
    const int tid = threadIdx.x, wid = __builtin_amdgcn_readfirstlane(tid >> 6), lane = tid & 63, wr = wid >> 2, wc = wid & 3, fr = lane & 15, fq = lane >> 4;
    const int K = g.K, nt = K / BK;
    unsigned voffA[2], voffB[2];
#pragma unroll
    for (int i = 0; i < 2; ++i) { int R, C; stage_rc(tid * 16 + i * 8192, R, C); const int Rb = (R & ~31) + perm32(R & 31);
        voffA[i] = (unsigned)(R * K + C) * 2u; voffB[i] = (unsigned)(Rb * K + C) * 2u; }
    const size_t kstep = (size_t)(BK * 2);
    const size_t hstep = (size_t)HALF * K * 2;
    const size_t tstep = 2 * hstep;
    const unsigned ldsw = (unsigned)wid * 1024u;
    const int aoff = lds_byte(wr * 64 + fr, fq * 8), boff = lds_byte(wc * 32 + fr, fq * 8);
#define PG8_SA(b, h) (((b) * 2 + (h)) * HTB)
#define PG8_SB(b, h) ((4 + (b) * 2 + (h)) * HTB)
#define PG8_STAGE(bufoff, gbase, voff) do { _Pragma("unroll") for (int _i = 0; _i < 2; ++_i) \
        __builtin_amdgcn_global_load_lds((const unsigned*)((const char*)(gbase) + (voff)[_i]), (LAS unsigned*)(lds + (bufoff) + ldsw + _i * 8192), 16, 0, 0); } while (0)
#define PG8_LDA(dst, b, h) do { _Pragma("unroll") for (int m = 0; m < 4; ++m) _Pragma("unroll") for (int k = 0; k < 2; ++k) dst[m][k] = *(const LAS bf16x8*)(lds + PG8_SA(b, h) + aoff + m * 2048 + k * 1024); } while (0)
#define PG8_LDB(dst, b, h) do { _Pragma("unroll") for (int n = 0; n < 2; ++n) _Pragma("unroll") for (int k = 0; k < 2; ++k) dst[n][k] = *(const LAS bf16x8*)(lds + PG8_SB(b, h) + boff + n * 2048 + k * 1024); } while (0)
#define PG8_MMA(ai, bj, At, Bt) do { __builtin_amdgcn_s_setprio(1); _Pragma("unroll") for (int m = 0; m < 4; ++m) _Pragma("unroll") for (int n = 0; n < 2; ++n) _Pragma("unroll") for (int k = 0; k < 2; ++k) \
        acc[ai][bj][m][n] = __builtin_amdgcn_mfma_f32_16x16x32_bf16(Bt[n][k], At[m][k], acc[ai][bj][m][n], 0, 0, 0); __builtin_amdgcn_s_setprio(0); } while (0)
#define PG8_WAIT_V(n) asm volatile("s_waitcnt vmcnt(" #n ")" ::: "memory")
#define PG8_WAIT_L(n) asm volatile("s_waitcnt lgkmcnt(" #n ")" ::: "memory")
#define PG8_BAR __builtin_amdgcn_s_barrier()
#define PG8_SCHED __builtin_amdgcn_sched_barrier(0)
    Unit cur, nxt; int ui = 0;
    if (!S.next(0, cur)) return;
    f32x4 acc[2][2][4][2];
#pragma unroll
    for (int a = 0; a < 2; ++a)
#pragma unroll
        for (int b = 0; b < 2; ++b)
#pragma unroll
            for (int m = 0; m < 4; ++m)
#pragma unroll
                for (int n = 0; n < 2; ++n) acc[a][b][m][n] = (f32x4){0.f, 0.f, 0.f, 0.f};
    bf16x8 At[4][2], B0[2][2], B1[2][2];
    const char* cA = (const char*)g.A + (size_t)cur.pm * tstep; const char* cB = (const char*)g.Bt + (size_t)cur.pn * tstep;
    if constexpr (SP2) {
        PG8_STAGE(PG8_SB(0, 0), cB, voffB); PG8_STAGE(PG8_SB(0, 1), cB + hstep, voffB); PG8_STAGE(PG8_SA(0, 0), cA, voffA); PG8_STAGE(PG8_SA(0, 1), cA + hstep, voffA);
        if (wr == 1) PG8_BAR;
        PG8_WAIT_V(2); PG8_BAR;
        PG8_STAGE(PG8_SB(1, 0), cB + kstep, voffB); PG8_STAGE(PG8_SA(1, 0), cA + kstep, voffA); PG8_STAGE(PG8_SB(1, 1), cB + hstep + kstep, voffB);
        PG8_WAIT_V(6); PG8_BAR;
    } else {
        PG8_STAGE(PG8_SB(0, 0), cB, voffB); PG8_STAGE(PG8_SA(0, 0), cA, voffA); PG8_STAGE(PG8_SB(0, 1), cB + hstep, voffB); PG8_STAGE(PG8_SA(0, 1), cA + hstep, voffA);
        if (wr == 1) PG8_BAR;
        PG8_WAIT_V(4); PG8_BAR;
        PG8_STAGE(PG8_SB(1, 0), cB + kstep, voffB); PG8_STAGE(PG8_SA(1, 0), cA + kstep, voffA); PG8_STAGE(PG8_SB(1, 1), cB + hstep + kstep, voffB);
        PG8_WAIT_V(6); PG8_BAR;
    }
    for (;;) {
        const bool has_next = S.next(ui + 1, nxt);
        const char* nA = has_next ? (const char*)g.A + (size_t)nxt.pm * tstep : cA; const char* nB = has_next ? (const char*)g.Bt + (size_t)nxt.pn * tstep : cB;
        for (int t = 0; t < nt; t += 2) {
            const bool last = (t == nt - 2);
            const char* a1 = cA + (size_t)(t + 1) * kstep;
            const char* a2 = last ? nA : cA + (size_t)(t + 2) * kstep; const char* b2 = last ? nB : cB + (size_t)(t + 2) * kstep;
            const char* a3 = a2 + kstep; const char* b3 = b2 + kstep;
            if constexpr (SP2) {
            PG8_LDB(B0, 0, 0); PG8_LDB(B1, 0, 1); PG8_SCHED; PG8_LDA(At, 0, 0); PG8_STAGE(PG8_SA(1, 1), a1 + hstep, voffA);
            PG8_WAIT_V(8); PG8_WAIT_L(0); PG8_BAR; PG8_MMA(0, 0, At, B0); PG8_MMA(0, 1, At, B1); PG8_BAR; PG8_SCHED;
            PG8_LDA(At, 0, 1); PG8_STAGE(PG8_SB(0, 0), b2, voffB); PG8_STAGE(PG8_SB(0, 1), b2 + hstep, voffB); PG8_STAGE(PG8_SA(0, 0), a2, voffA);
            PG8_WAIT_V(8); PG8_WAIT_L(0); PG8_BAR; PG8_MMA(1, 0, At, B0); PG8_MMA(1, 1, At, B1); PG8_BAR; PG8_SCHED;
            PG8_LDB(B0, 1, 0); PG8_LDB(B1, 1, 1); PG8_SCHED; PG8_LDA(At, 1, 0); PG8_STAGE(PG8_SA(0, 1), a2 + hstep, voffA);
            PG8_WAIT_V(8); PG8_WAIT_L(0); PG8_BAR; PG8_MMA(0, 0, At, B0); PG8_MMA(0, 1, At, B1); PG8_BAR; PG8_SCHED;
            PG8_LDA(At, 1, 1); PG8_STAGE(PG8_SB(1, 0), b3, voffB); PG8_STAGE(PG8_SB(1, 1), b3 + hstep, voffB); PG8_STAGE(PG8_SA(1, 0), a3, voffA);
            PG8_WAIT_V(8); PG8_WAIT_L(0); PG8_BAR; PG8_MMA(1, 0, At, B0); PG8_MMA(1, 1, At, B1); PG8_BAR; PG8_SCHED;
            } else {
            PG8_LDB(B0, 0, 0); PG8_SCHED; PG8_LDA(At, 0, 0); PG8_STAGE(PG8_SA(1, 1), a1 + hstep, voffA);
            PG8_WAIT_L(8); PG8_BAR; PG8_WAIT_L(0); PG8_MMA(0, 0, At, B0); PG8_BAR; PG8_SCHED;
            PG8_LDB(B1, 0, 1); PG8_STAGE(PG8_SB(0, 0), b2, voffB);
            PG8_BAR; PG8_WAIT_L(0); PG8_MMA(0, 1, At, B1); PG8_BAR;
            PG8_LDA(At, 0, 1); PG8_STAGE(PG8_SA(0, 0), a2, voffA);
            PG8_BAR; PG8_WAIT_L(0); PG8_MMA(1, 0, At, B0); PG8_BAR; PG8_SCHED;
            PG8_STAGE(PG8_SB(0, 1), b2 + hstep, voffB);
            PG8_WAIT_V(6); PG8_BAR; PG8_MMA(1, 1, At, B1); PG8_BAR;
            PG8_LDB(B0, 1, 0); PG8_SCHED; PG8_LDA(At, 1, 0); PG8_STAGE(PG8_SA(0, 1), a2 + hstep, voffA);
            PG8_WAIT_L(8); PG8_BAR; PG8_WAIT_L(0); PG8_MMA(0, 0, At, B0); PG8_BAR; PG8_SCHED;
            PG8_LDB(B1, 1, 1); PG8_STAGE(PG8_SB(1, 0), b3, voffB);
            PG8_BAR; PG8_WAIT_L(0); PG8_MMA(0, 1, At, B1); PG8_BAR;
            PG8_LDA(At, 1, 1); PG8_STAGE(PG8_SA(1, 0), a3, voffA);
            PG8_BAR; PG8_WAIT_L(0); PG8_MMA(1, 0, At, B0); PG8_BAR; PG8_SCHED;
            PG8_STAGE(PG8_SB(1, 1), b3 + hstep, voffB);
            PG8_WAIT_V(6); PG8_BAR; PG8_MMA(1, 1, At, B1); PG8_BAR;
            }
        }
        if constexpr (ALIGN_EPI) { if (wr == 0) PG8_BAR; }
        E(acc, cur, wr, wc, fr, fq);
        if (!has_next) break;
#pragma unroll
        for (int a = 0; a < 2; ++a)
#pragma unroll
            for (int b = 0; b < 2; ++b)
#pragma unroll
                for (int m = 0; m < 4; ++m)
#pragma unroll
                    for (int n = 0; n < 2; ++n) acc[a][b][m][n] = (f32x4){0.f, 0.f, 0.f, 0.f};
        cur = nxt; cA = nA; cB = nB; ++ui;
        if constexpr (ALIGN_EPI) { if (wr == 1) PG8_BAR; }
    }
    PG8_WAIT_V(0);
    if constexpr (!ALIGN_EPI) { if (wr == 0) PG8_BAR; }
    PG8_BAR;
#undef PG8_SA
#undef PG8_SB
#undef PG8_STAGE
#undef PG8_LDA
#undef PG8_LDB
#undef PG8_MMA
#undef PG8_WAIT_V
#undef PG8_WAIT_L
#undef PG8_BAR
#undef PG8_SCHED
}
}

constexpr int DM = 2048, NB = 4, SEQ = 4096, CL = 256, RPB = SEQ + CL, MROWS = NB * RPB, MT = MROWS / 256;
constexpr int NE = 64, FF = 512, A_IN = 4608;
constexpr int XS_BLK = 472, SH_BLK = 68;
constexpr float DN_ALPHA = 1.4142135623730951f;
constexpr float LN_EPS = 1e-5f, RMS_EPS = 1e-6f;

constexpr size_t MiB = 1u << 20;
constexpr size_t WS_CTL = 0, CTL_ZERO_BYTES = 1 * MiB;
constexpr size_t WS_MOD = 1 * MiB;
constexpr size_t WS_ROPE128 = 2 * MiB;
constexpr size_t WS_ROPE64 = 4 * MiB;
constexpr size_t WS_TE = 5 * MiB;
constexpr size_t WS_TW = 6 * MiB;
constexpr size_t WS_INV = 7 * MiB;
constexpr size_t WS_BLKE = 7 * MiB + 768 * 1024;
constexpr size_t WS_W_IN = 8 * MiB;
constexpr size_t WS_W_OUT0 = 26 * MiB;
constexpr size_t WS_W_DOWN = 34 * MiB;
constexpr size_t WS_W_UQKV = 39 * MiB;
constexpr size_t WS_W_OUT1 = 46 * MiB;
constexpr size_t WS_W_RT = 54 * MiB;
constexpr size_t WS_W_GU = 56 * MiB;
constexpr size_t WS_W_D = 576 * MiB;
constexpr size_t WS_X = 836 * MiB;
constexpr size_t WS_UM = 972 * MiB;
constexpr size_t WS_XS = 1040 * MiB;
constexpr size_t WS_U = WS_XS + (size_t)XS_BLK * MiB;
constexpr size_t WS_ULO = WS_U + (size_t)SH_BLK * MiB;
constexpr size_t WS_Y = WS_XS;
constexpr size_t WS_H = 1648 * MiB;
constexpr size_t WS_PROJ = 1783 * MiB;
constexpr size_t WS_Y1_0 = WS_PROJ;
constexpr size_t WS_MIX = 1936 * MiB;
constexpr size_t WS_LOG = 2004 * MiB;
constexpr size_t WS_END = 2021 * MiB;
constexpr size_t WS_DOWNP = 1040 * MiB;
constexpr size_t WS_CQKV = 1083 * MiB;
constexpr size_t WS_KR = 1117 * MiB;
constexpr size_t WS_QB = 1120 * MiB;
constexpr size_t WS_KVB = 1222 * MiB;
constexpr size_t WS_ATT = 1358 * MiB;
constexpr size_t WS_Y1_1 = 1426 * MiB;
static_assert(WS_Y1_1 + 68 * MiB <= WS_U, "layer-1 mixer buffers inside XS");
constexpr size_t W_GU_L = (size_t)65 * 1024 * 2048, W_D_L = (size_t)65 * 2048 * 512;

constexpr int CW_TMO = 0, CW_BAR = 4096, CW_CNT = 8192, CW_NBLK = 8192 + 256;

constexpr int LDS_BYTES = 155648, RING_BYTES = 147456, MISC_OFF = RING_BYTES + 320;

#define XB_TMO      128
#define XB_XCNT(j)  (256  + 64 * (j))
#define XB_XSUB(j)  (1280 + 64 * (j))
#define XB_XGEN(j)  (2304 + 64 * (j))
#define XB_TOP      3328
#define XB_TOPGEN   3392
#define XCD_BAR_WORDS 3456
#define XB_SPIN_CAP (1u << 18)
__device__ __forceinline__ unsigned xb_ld(unsigned* p)              { return __hip_atomic_load(p, __ATOMIC_RELAXED, __HIP_MEMORY_SCOPE_AGENT); }
__device__ __forceinline__ unsigned xb_add(unsigned* p, unsigned v) { return __hip_atomic_fetch_add(p, v, __ATOMIC_RELAXED, __HIP_MEMORY_SCOPE_AGENT); }
__device__ __forceinline__ unsigned xb_xcc_id() { return (unsigned)__builtin_amdgcn_s_getreg((3 << 11) | 20) & 0xFu; }
#define XB_SPIN(cond, bar) do { unsigned _sp = 0; while (cond) { __builtin_amdgcn_s_sleep(1); \
    if ((++_sp & 255u) == 0u) { if (xb_ld(&(bar)[XB_TMO])) break; if (_sp > XB_SPIN_CAP) { atomicAdd(&(bar)[XB_TMO], 1u); break; } } } } while (0)
struct XcdBarrier { unsigned* bar; unsigned x; volatile LAS unsigned* st; };
__device__ __forceinline__ XcdBarrier xcd_barrier_post(unsigned* bar, volatile LAS unsigned* st) {
    XcdBarrier b; b.bar = bar; b.x = xb_xcc_id(); b.st = st;
    if (threadIdx.x == 0) (void)xb_add(&bar[XB_XCNT(b.x)], 1u);
    return b;
}
__device__ __forceinline__ void xcd_barrier_complete(unsigned* bar, unsigned x, unsigned& nloc, unsigned& nx) {
    const unsigned G = gridDim.x * gridDim.y * gridDim.z;
    unsigned sum, cnt, mine, sp = 0u;
    for (;;) {
        sum = 0u; cnt = 0u; mine = 0u;
#pragma unroll
        for (unsigned j = 0; j < 16; ++j) { const unsigned c = xb_ld(&bar[XB_XCNT(j)]); sum += c; cnt += (c > 0u) ? 1u : 0u; mine = (j == x) ? c : mine; }
        if (sum == G) break;
        __builtin_amdgcn_s_sleep(1);
        if ((++sp & 255u) == 0u) { if (xb_ld(&bar[XB_TMO])) break; if (sp > XB_SPIN_CAP) { atomicAdd(&bar[XB_TMO], 1u); break; } }
    }
    nloc = mine > 0u ? mine : 1u; nx = cnt > 0u ? cnt : 1u;
}
__device__ __forceinline__ void xcd_barrier(const XcdBarrier& b) {
    asm volatile("s_waitcnt vmcnt(0)" ::: "memory");
    __syncthreads();
    if (threadIdx.x == 0) {
        unsigned* bar = b.bar;
        __builtin_amdgcn_s_waitcnt(0);
        unsigned nloc = b.st[0], nx = b.st[1];
        if (nloc == 0u) { xcd_barrier_complete(bar, b.x, nloc, nx); b.st[0] = nloc; b.st[1] = nx; }
        const unsigned old = xb_add(&bar[XB_XSUB(b.x)], 1u);
        const unsigned gen = old / nloc;
        if (old + 1u == (gen + 1u) * nloc) {
            __builtin_amdgcn_fence(__ATOMIC_RELEASE, "agent");
            asm volatile("s_waitcnt vmcnt(0)" ::: "memory");
            const unsigned og = xb_add(&bar[XB_TOP], 1u);
            const unsigned tg = og / nx;
            if (og + 1u == (tg + 1u) * nx) xb_add(&bar[XB_TOPGEN], 1u);
            else XB_SPIN(xb_ld(&bar[XB_TOPGEN]) == tg, bar);
            __builtin_amdgcn_fence(__ATOMIC_ACQUIRE, "agent");
            xb_add(&bar[XB_XGEN(b.x)], 1u);
            asm volatile("s_waitcnt vmcnt(0)" ::: "memory");
        } else {
            XB_SPIN(xb_ld(&bar[XB_XGEN(b.x)]) == gen, bar);
            __builtin_amdgcn_fence(__ATOMIC_ACQUIRE, "agent");
            asm volatile("s_waitcnt vmcnt(0)" ::: "memory");
        }
    }
    __syncthreads();
}

struct Args { const float* in[27]; float* out; unsigned char* ws; int ph_lo, ph_hi; };
enum { I_X = 0, I_C, I_CTX, I_CCTX, I_WADA, I_BADA, I_LNG, I_LNB, I_AWIN, I_ACONV, I_AQG, I_AKG, I_AWOUT, I_MWDOWN, I_MQG, I_MKVG, I_MWUQ, I_MWUKV, I_MWOUT,
       I_RW, I_RB, I_EWG, I_EWU, I_EWD, I_SWG, I_SWU, I_SWD };

struct Ctx {
    LAS unsigned char* lds; int tid, lane, wave, G, bid, vcu, gw, ngw;
    unsigned char* ws; unsigned* ctl;
};
__device__ __forceinline__ void row_info(int r, int& b, int& p) { b = r / RPB; p = r - b * RPB; }
__device__ __forceinline__ const float* in_row(const Args& a, int b, int p) {
    return p < CL ? a.in[I_CTX] + ((size_t)(b * CL + p)) * DM : a.in[I_X] + ((size_t)(b * SEQ + (p - CL))) * DM;
}

template <bool SPLIT>
__device__ __forceinline__ void tr_item(const float* __restrict__ src, int ldw, bf16* dst, bf16* dst_lo, int ldd, LAS float* scr, int lane) {
#pragma unroll 8
    for (int i = 0; i < 32; ++i) { const int kk = 2 * i + (lane >> 5); scr[kk * 33 + (lane & 31)] = src[(size_t)kk * ldw + (lane & 31)]; }
    LDS_WAIT(); asm volatile("" ::: "memory");
    const int c = lane & 7;
#pragma unroll
    for (int j = 0; j < 4; ++j) { const int n = (lane >> 3) + 8 * j; const LAS float* s = scr + (8 * c) * 33 + n;
        float v[8];
#pragma unroll
        for (int q = 0; q < 8; ++q) v[q] = s[q * 33];
        u32x4 o; o.x = cvt_pk_bf16(v[0], v[1]); o.y = cvt_pk_bf16(v[2], v[3]); o.z = cvt_pk_bf16(v[4], v[5]); o.w = cvt_pk_bf16(v[6], v[7]);
        *(u32x4*)(dst + (size_t)n * ldd + 8 * c) = o;
        if constexpr (SPLIT) {
            u32x4 l; l.x = cvt_pk_bf16(v[0] - bf_lo(o.x), v[1] - bf_hi(o.x)); l.y = cvt_pk_bf16(v[2] - bf_lo(o.y), v[3] - bf_hi(o.y));
            l.z = cvt_pk_bf16(v[4] - bf_lo(o.z), v[5] - bf_hi(o.z)); l.w = cvt_pk_bf16(v[6] - bf_lo(o.w), v[7] - bf_hi(o.w));
            *(u32x4*)(dst_lo + (size_t)n * ldd + 8 * c) = l;
        }
    }
    LDS_WAIT(); asm volatile("" ::: "memory");
}

__device__ __forceinline__ void p0_prologue(const Ctx& C, const Args& a) {
    unsigned char* ws = C.ws;
    {
        LAS float* sv = (LAS float*)C.lds;
        LAS float* red = (LAS float*)(C.lds + 40960);
        for (int i = C.tid; i < 5 * DM; i += 512) { const int r = i / DM, k = i - r * DM; const float c = (r < 4) ? a.in[I_C][r * DM + k] : a.in[I_CCTX][k]; sv[i] = c / (1.f + __expf(-c)); }
        __syncthreads();
        float* mod = (float*)(ws + WS_MOD);
        for (int chunk = C.bid; chunk < 256; chunk += C.G) {
            const int l = chunk >> 7, col0 = (chunk & 127) * 96;
            if (C.tid < 384) {
                const int cg = C.tid % 24, ks = C.tid / 24;
                f32x4 acc[5];
#pragma unroll
                for (int r = 0; r < 5; ++r) acc[r] = (f32x4){0.f, 0.f, 0.f, 0.f};
                const float* W = a.in[I_WADA] + ((size_t)l * DM + ks * 128) * 12288 + col0 + 4 * cg;
                const LAS float* s0 = sv + ks * 128;
#pragma unroll 8
                for (int k = 0; k < 128; ++k) { const f32x4 w = *(const f32x4*)(W + (size_t)k * 12288);
#pragma unroll
                    for (int r = 0; r < 5; ++r) { const float s = s0[r * DM + k]; acc[r] += w * s; } }
#pragma unroll
                for (int r = 0; r < 5; ++r) *(LAS f32x4*)(red + (ks * 5 + r) * 96 + 4 * cg) = acc[r];
            }
            __syncthreads();
            if (C.tid < 480) { const int r = C.tid / 96, c = C.tid - r * 96; float s = a.in[I_BADA][l * 12288 + col0 + c];
#pragma unroll
                for (int ks = 0; ks < 16; ++ks) s += red[(ks * 5 + r) * 96 + c];
                mod[((size_t)l * 5 + r) * 12288 + col0 + c] = s; }
            __syncthreads();
        }
    }
    {
        f32x2* r128 = (f32x2*)(ws + WS_ROPE128); f32x2* r64 = (f32x2*)(ws + WS_ROPE64);
        const int gt = C.bid * 512 + C.tid, ngt = C.G * 512;
        for (int i = gt; i < SEQ * 64; i += ngt) { const int s = i >> 6, j = i & 63; const float pos = (float)((j < 32) ? (s >> 6) : (s & 63)); const int f = j & 31;
            const float inv = exp2f(-(float)f * (13.287712379549449f / 32.f)); const float ang = pos * inv; r128[i] = (f32x2){cosf(ang), sinf(ang)}; }
        for (int i = gt; i < SEQ * 32; i += ngt) { const int s = i >> 5, j = i & 31; const float pos = (float)((j < 16) ? (s >> 6) : (s & 63)); const int f = j & 15;
            const float inv = exp2f(-(float)f * (13.287712379549449f / 16.f)); const float ang = pos * inv; r64[i] = (f32x2){cosf(ang), sinf(ang)}; }
        const u32x4 z = {0u, 0u, 0u, 0u};
        u32x4* zd = (u32x4*)(ws + WS_W_DOWN + (size_t)1088 * 4096);
        for (int i = gt; i < 192 * 256; i += ngt) zd[i] = z;
        for (int l = 0; l < 2; ++l) { u32x4* zr = (u32x4*)(ws + WS_W_RT + (size_t)l * 256 * 4096 + (size_t)128 * 4096); for (int i = gt; i < 128 * 256; i += ngt) zr[i] = z; }
    }
    __syncthreads();
    {
        LAS float* scr = (LAS float*)(C.lds + C.wave * 16384);
        constexpr int J0 = 32 * 144, J1 = 32 * 64, J2 = 32 * 34, J3 = 8 * 96, J4 = 8 * 128, J5 = 32 * 64, J6 = 2 * 32 * 2, J7 = 2 * 64 * 512, J8 = J7, J9 = 2 * 64 * 512, J10 = 2 * 512, J11 = J10, J12 = 2 * 512;
        constexpr int NITEMS = J0 + J1 + J2 + J3 + J4 + J5 + J6 + J7 + J8 + J9 + J10 + J11 + J12;
        bf16* w_in = (bf16*)(ws + WS_W_IN); bf16* w_out0 = (bf16*)(ws + WS_W_OUT0); bf16* w_down = (bf16*)(ws + WS_W_DOWN); bf16* w_uqkv = (bf16*)(ws + WS_W_UQKV);
        bf16* w_out1 = (bf16*)(ws + WS_W_OUT1); bf16* w_rt = (bf16*)(ws + WS_W_RT); bf16* w_gu = (bf16*)(ws + WS_W_GU); bf16* w_d = (bf16*)(ws + WS_W_D);
        for (int it = C.gw; it < NITEMS; it += C.ngw) {
            int r = it;
            if (r < J0) { const int kb = r / 144, nb = r % 144; tr_item<false>(a.in[I_AWIN] + (size_t)kb * 64 * A_IN + nb * 32, A_IN, w_in + (size_t)nb * 32 * DM + kb * 64, nullptr, DM, scr, C.lane); continue; } r -= J0;
            if (r < J1) { const int kb = r / 64, nb = r % 64; tr_item<false>(a.in[I_AWOUT] + (size_t)kb * 64 * DM + nb * 32, DM, w_out0 + (size_t)nb * 32 * DM + kb * 64, nullptr, DM, scr, C.lane); continue; } r -= J1;
            if (r < J2) { const int kb = r / 34, nb = r % 34; tr_item<false>(a.in[I_MWDOWN] + (size_t)kb * 64 * 1088 + nb * 32, 1088, w_down + (size_t)nb * 32 * DM + kb * 64, nullptr, DM, scr, C.lane); continue; } r -= J2;
            if (r < J3) { const int kb = r / 96, nb = r % 96; const int n0 = nb * 32, h = n0 / 192, d = n0 - h * 192;
                const int row = (d < 128) ? (128 * h + d) : (2048 + 256 * (h >> 2) + ((d - 128) ? 128 : 0) + 32 * (h & 3));
                tr_item<false>(a.in[I_MWUQ] + (size_t)kb * 64 * 3072 + n0, 3072, w_uqkv + (size_t)row * 512 + kb * 64, nullptr, 512, scr, C.lane); continue; } r -= J3;
            if (r < J4) { const int kb = r / 128, nb = r % 128; tr_item<false>(a.in[I_MWUKV] + (size_t)kb * 64 * 4096 + nb * 32, 4096, w_uqkv + (size_t)(3072 + nb * 32) * 512 + kb * 64, nullptr, 512, scr, C.lane); continue; } r -= J4;
            if (r < J5) { const int kb = r / 64, nb = r % 64; tr_item<false>(a.in[I_MWOUT] + (size_t)kb * 64 * DM + nb * 32, DM, w_out1 + (size_t)nb * 32 * DM + kb * 64, nullptr, DM, scr, C.lane); continue; } r -= J5;
            if (r < J6) { const int l = r / 64, q = r % 64, kb = q / 2, nb = q % 2; bf16* d = w_rt + (size_t)l * 256 * DM + (size_t)nb * 32 * DM + kb * 64;
                tr_item<true>(a.in[I_RW] + ((size_t)l * DM + kb * 64) * 64 + nb * 32, 64, d, d + (size_t)64 * DM, DM, scr, C.lane); continue; } r -= J6;
            if (r < J7 + J8) { const int up = r >= J7; if (up) r -= J7; const int le = r / 512, q = r % 512, kb = q / 16, nb = q % 16, n0 = nb * 32, l = le >> 6, e = le & 63;
                const float* src = (up ? a.in[I_EWU] : a.in[I_EWG]) + ((size_t)le * DM + kb * 64) * FF + n0;
                bf16* d = w_gu + (size_t)l * W_GU_L + ((size_t)e * 1024 + 256 * (n0 >> 7) + (up ? 128 : 0) + (n0 & 127)) * DM + kb * 64;
                tr_item<false>(src, FF, d, nullptr, DM, scr, C.lane); continue; } r -= J7 + J8;
            if (r < J9) { const int le = r / 512, q = r % 512, kb = q / 64, nb = q % 64, l = le >> 6, e = le & 63;
                tr_item<false>(a.in[I_EWD] + ((size_t)le * FF + kb * 64) * DM + nb * 32, DM, w_d + (size_t)l * W_D_L + ((size_t)e * 2048 + nb * 32) * FF + kb * 64, nullptr, FF, scr, C.lane); continue; } r -= J9;
            if (r < J10 + J11) { const int up = r >= J10; if (up) r -= J10; const int l = r / 512, q = r % 512, kb = q / 16, nb = q % 16, n0 = nb * 32;
                const float* src = (up ? a.in[I_SWU] : a.in[I_SWG]) + ((size_t)l * DM + kb * 64) * FF + n0;
                bf16* d = w_gu + (size_t)l * W_GU_L + ((size_t)NE * 1024 + 256 * (n0 >> 7) + (up ? 128 : 0) + (n0 & 127)) * DM + kb * 64;
                tr_item<false>(src, FF, d, nullptr, DM, scr, C.lane); continue; } r -= J10 + J11;
            { const int l = r / 512, q = r % 512, kb = q / 64, nb = q % 64;
                tr_item<false>(a.in[I_SWD] + ((size_t)l * FF + kb * 64) * DM + nb * 32, DM, w_d + (size_t)l * W_D_L + ((size_t)NE * 2048 + nb * 32) * FF + kb * 64, nullptr, FF, scr, C.lane); }
        }
    }
}

__device__ __forceinline__ void p1_modulate0(const Ctx& C, const Args& a) {
    const float* mod = (const float*)(C.ws + WS_MOD); bf16* um = (bf16*)(C.ws + WS_UM);
    for (int r = C.gw; r < MROWS; r += C.ngw) {
        int b, p; row_info(r, b, p); const float* xr = in_row(a, b, p); const float* mr = mod + (size_t)(p < CL ? 4 : b) * 12288;
#pragma unroll
        for (int j = 0; j < 8; ++j) { const int e = 4 * (C.lane + 64 * j); const f32x4 x = *(const f32x4*)(xr + e), sh = *(const f32x4*)(mr + e), sc = *(const f32x4*)(mr + 2048 + e);
            const f32x4 u = x * (sc + 1.f) + sh; u32x2 w; w.x = cvt_pk_bf16(u[0], u[1]); w.y = cvt_pk_bf16(u[2], u[3]); *(u32x2*)(um + (size_t)r * DM + e) = w; }
    }
}

struct EpiStoreBf16 {
    bf16* O; int ldc;
    __device__ __forceinline__ void operator()(const f32x4 (&acc)[2][2][4][2], const pg8::Unit& u, int wr, int wc, int fr, int fq) const {
        const int row0 = u.pm * 256 + wr * 64 + fr, col0 = u.pn * 256 + wc * 32 + 8 * fq;
#pragma unroll
        for (int ai = 0; ai < 2; ++ai)
#pragma unroll
            for (int m = 0; m < 4; ++m) { bf16* rowp = O + (size_t)(row0 + ai * 128 + m * 16) * ldc + col0;
#pragma unroll
                for (int bj = 0; bj < 2; ++bj) { const f32x4 v0 = acc[ai][bj][m][0], v1 = acc[ai][bj][m][1];
                    u32x4 w; w.x = cvt_pk_bf16(v0[0], v0[1]); w.y = cvt_pk_bf16(v0[2], v0[3]); w.z = cvt_pk_bf16(v1[0], v1[1]); w.w = cvt_pk_bf16(v1[2], v1[3]);
                    *(u32x4*)(rowp + bj * 128) = w; } }
    }
};
struct DenseSched {
    int nM, nN, G, c, lat_only, pm_off, pn_off;
    __device__ __forceinline__ bool next(int i, pg8::Unit& u) const {
        const long L = (long)i * G + c; const int nwg = nM * nN; if (L >= nwg) return false;
        const int w = pg8::xcd_remap((int)L, nwg); int pm, pn; pg8::tile_of(w, nM, nN, pm, pn);
        if (lat_only) pm = 17 * (pm >> 4) + 1 + (pm & 15);
        u.pm = pm + pm_off; u.pn = pn + pn_off; return true;
    }
};

__device__ __forceinline__ void p3_qk_conv(const Ctx& C, const Args& a) {
    bf16* proj = (bf16*)(C.ws + WS_PROJ); bf16* mix = (bf16*)(C.ws + WS_MIX);
    const f32x2* rope = (const f32x2*)(C.ws + WS_ROPE128);
    const float qg0 = a.in[I_AQG][C.lane], qg1 = a.in[I_AQG][C.lane + 64], kg0 = a.in[I_AKG][C.lane], kg1 = a.in[I_AKG][C.lane + 64];
    const float* cw = a.in[I_ACONV];
    for (int r = C.gw; r < MROWS; r += C.ngw) {
        int b, p; row_info(r, b, p); const bool isctx = p < CL;
        bf16* pr = proj + (size_t)r * A_IN;
        f32x2 cs = {1.f, 0.f}; if (!isctx) cs = rope[(size_t)(p - CL) * 64 + C.lane];
#pragma unroll
        for (int h = 0; h < 10; ++h) {
            bf16* hp = pr + 3072 + 128 * h;
            const float x1 = bf2f(hp[C.lane]), x2 = bf2f(hp[C.lane + 64]);
            const float ss = wave_sum(x1 * x1 + x2 * x2);
            const float rs = 1.f / sqrtf(ss * (1.f / 128.f) + RMS_EPS);
            const float y1 = x1 * rs * (h < 8 ? qg0 : kg0), y2 = x2 * rs * (h < 8 ? qg1 : kg1);
            hp[C.lane] = (bf16)f2bf(y1 * cs.x - y2 * cs.y); hp[C.lane + 64] = (bf16)f2bf(y2 * cs.x + y1 * cs.y);
        }
        const int pos = isctx ? p : p - CL, len = isctx ? CL : SEQ;
        const bool hasm = pos > 0, hasp = pos + 1 < len;
#pragma unroll
        for (int j = 0; j < 2; ++j) {
            const int c0 = 8 * (C.lane + 64 * j);
            const u32x4 gb = *(const u32x4*)(pr + c0), gc = *(const u32x4*)(pr + 1024 + c0), hv = *(const u32x4*)(pr + 2048 + c0);
            u32x4 gcm = {0u, 0u, 0u, 0u}, hvm = gcm, gcp = gcm, hvp = gcm;
            if (hasm) { gcm = *(const u32x4*)(pr - A_IN + 1024 + c0); hvm = *(const u32x4*)(pr - A_IN + 2048 + c0); }
            if (hasp) { gcp = *(const u32x4*)(pr + A_IN + 1024 + c0); hvp = *(const u32x4*)(pr + A_IN + 2048 + c0); }
            const f32x4 w0a = *(const f32x4*)(cw + c0), w0b = *(const f32x4*)(cw + c0 + 4), w1a = *(const f32x4*)(cw + 1024 + c0), w1b = *(const f32x4*)(cw + 1024 + c0 + 4),
                        w2a = *(const f32x4*)(cw + 2048 + c0), w2b = *(const f32x4*)(cw + 2048 + c0 + 4);
            float o[8];
#pragma unroll
            for (int q = 0; q < 4; ++q) {
                const float w0l = q < 2 ? w0a[2 * q] : w0b[2 * q - 4], w0h = q < 2 ? w0a[2 * q + 1] : w0b[2 * q - 3];
                const float w1l = q < 2 ? w1a[2 * q] : w1b[2 * q - 4], w1h = q < 2 ? w1a[2 * q + 1] : w1b[2 * q - 3];
                const float w2l = q < 2 ? w2a[2 * q] : w2b[2 * q - 4], w2h = q < 2 ? w2a[2 * q + 1] : w2b[2 * q - 3];
                const float zl = bf_lo(gc[q]) * bf_lo(hv[q]), zh = bf_hi(gc[q]) * bf_hi(hv[q]);
                const float zml = bf_lo(gcm[q]) * bf_lo(hvm[q]), zmh = bf_hi(gcm[q]) * bf_hi(hvm[q]);
                const float zpl = bf_lo(gcp[q]) * bf_lo(hvp[q]), zph = bf_hi(gcp[q]) * bf_hi(hvp[q]);
                o[2 * q] = bf_lo(gb[q]) * (w0l * zml + w1l * zl + w2l * zpl);
                o[2 * q + 1] = bf_hi(gb[q]) * (w0h * zmh + w1h * zh + w2h * zph);
            }
            u32x4 w; w.x = cvt_pk_bf16(o[0], o[1]); w.y = cvt_pk_bf16(o[2], o[3]); w.z = cvt_pk_bf16(o[4], o[5]); w.w = cvt_pk_bf16(o[6], o[7]);
            *(u32x4*)(mix + (size_t)r * DM + c0) = w;
        }
    }
}

namespace att {
constexpr int NW = 8, QBLK = 32, KVBLK = 64;
constexpr int SHM_V = KVBLK * 128 * 2, SHM_K = KVBLK * 128 * 2, SHM_KR = KVBLK * 64 * 2;
constexpr int OFF_V = 0, OFF_K = 2 * SHM_V, OFF_KR = 2 * SHM_V + 2 * SHM_K, OFF_QR = OFF_KR + 2 * SHM_KR, LDS_ATT = OFF_QR + NW * 8192;
constexpr float THR = 8.f;
#define KSWZ(row, colB) ((row) * 256 + ((colB) ^ (((row) & 7) << 4)))
#define KRSWZ(row, colB) ((row) * 128 + ((colB) ^ (((row) & 7) << 4)))
__device__ __forceinline__ bf16x8 ld8(const bf16* p) { return *reinterpret_cast<const bf16x8*>(p); }

__device__ __forceinline__ void partialSM(f32x16& p0, f32x16& p1, float& m_reg, float& mn, float& alpha, const float SCALE) {
    const float Cc = SCALE * 1.4426950408889634f;
    float pmax = p0[0];
#pragma unroll
    for (int r = 1; r < 16; ++r) pmax = fmaxf(pmax, p0[r]);
#pragma unroll
    for (int r = 0; r < 16; ++r) pmax = fmaxf(pmax, p1[r]);
    { auto rr = __builtin_amdgcn_permlane32_swap(__float_as_uint(pmax), __float_as_uint(pmax), false, false);
      pmax = fmaxf(__uint_as_float(rr[0]), __uint_as_float(rr[1])); }
    if (__builtin_expect(__all(pmax - m_reg <= THR / SCALE), 1)) { mn = m_reg; alpha = 1.f; }
    else { mn = fmaxf(m_reg, pmax); alpha = __builtin_amdgcn_exp2f((m_reg - mn) * Cc); m_reg = mn; }
    const float mnC = -mn * Cc;
#pragma unroll
    for (int r = 0; r < 16; ++r) p0[r] = fmaf(p0[r], Cc, mnC);
#pragma unroll
    for (int r = 0; r < 16; ++r) p1[r] = fmaf(p1[r], Cc, mnC);
#pragma unroll
    for (int r = 0; r < 16; ++r) p0[r] = __builtin_amdgcn_exp2f(p0[r]);
}
__device__ __forceinline__ void finishSM(f32x16& p0, f32x16& p1, float alpha, float& l_reg, bf16x8& pa0, bf16x8& pa1, bf16x8& pa2, bf16x8& pa3) {
#pragma unroll
    for (int r = 0; r < 16; ++r) p1[r] = __builtin_amdgcn_exp2f(p1[r]);
    float ps = 0;
#pragma unroll
    for (int r = 0; r < 16; ++r) ps += p0[r];
#pragma unroll
    for (int r = 0; r < 16; ++r) ps += p1[r];
    { auto rr = __builtin_amdgcn_permlane32_swap(__float_as_uint(ps), __float_as_uint(ps), false, false);
      ps = __uint_as_float(rr[0]) + __uint_as_float(rr[1]); }
    l_reg = l_reg * alpha + ps;
#define PK4(P, BASE, OUT) do { unsigned a0 = cvt_pk_bf16(P[BASE + 0], P[BASE + 1]), a1 = cvt_pk_bf16(P[BASE + 2], P[BASE + 3]);   \
    unsigned b0 = cvt_pk_bf16(P[BASE + 4], P[BASE + 5]), b1 = cvt_pk_bf16(P[BASE + 6], P[BASE + 7]);                              \
    auto r0 = __builtin_amdgcn_permlane32_swap(a0, b0, false, false); auto r1 = __builtin_amdgcn_permlane32_swap(a1, b1, false, false); \
    u32x4 w = {r0[0], r1[0], r0[1], r1[1]}; OUT = *reinterpret_cast<bf16x8*>(&w); } while (0)
    PK4(p0, 0, pa0); PK4(p0, 8, pa1); PK4(p1, 0, pa2); PK4(p1, 8, pa3);
#undef PK4
}
#ifndef MLA_SD
#define MLA_SD 1
#endif
#ifndef MLA_NQL
#define MLA_NQL 4
#endif
template <int MLA>
__device__ __forceinline__ void qkt(f32x16& p0, f32x16& p1, const char* Ks, const char* Krs, const bf16x8* qr, const char* qrl, int r32, int hi) {
    constexpr int NQL = MLA ? MLA_NQL : 0;
    p0 = f32x16{}; p1 = f32x16{};
#pragma unroll
    for (int d0 = 0; d0 < 8; ++d0) { const int cb = (d0 * 16 + hi * 8) * 2;
        const bf16x8 b0 = *reinterpret_cast<const bf16x8*>(Ks + KSWZ(r32, cb));
        const bf16x8 b1 = *reinterpret_cast<const bf16x8*>(Ks + KSWZ(32 + r32, cb));
        bf16x8 qf; if (d0 < NQL) qf = *reinterpret_cast<const bf16x8*>(qrl + (4 + d0) * 1024); else qf = qr[d0 - NQL];
        p0 = __builtin_amdgcn_mfma_f32_32x32x16_bf16(b0, qf, p0, 0, 0, 0);
        p1 = __builtin_amdgcn_mfma_f32_32x32x16_bf16(b1, qf, p1, 0, 0, 0); }
    if constexpr (MLA) {
#pragma unroll
        for (int d0 = 0; d0 < 4; ++d0) { const int cb = (d0 * 16 + hi * 8) * 2;
            const bf16x8 b0 = *reinterpret_cast<const bf16x8*>(Krs + KRSWZ(r32, cb));
            const bf16x8 b1 = *reinterpret_cast<const bf16x8*>(Krs + KRSWZ(32 + r32, cb));
            const bf16x8 qf = *reinterpret_cast<const bf16x8*>(qrl + d0 * 1024);
            p0 = __builtin_amdgcn_mfma_f32_32x32x16_bf16(b0, qf, p0, 0, 0, 0);
            p1 = __builtin_amdgcn_mfma_f32_32x32x16_bf16(b1, qf, p1, 0, 0, 0); }
    }
}
__device__ __forceinline__ int v_st(int k, int c) { const int kk = (k & ~0xC) | ((k & 4) << 1) | ((k & 8) >> 1); return ((kk >> 3) * 4 + (c >> 5)) * 512 + ((kk & 7) * 32 + (c & 31)) * 2; }
__device__ __forceinline__ int v_rd_base(int lane) { return ((lane & 3) << 3) | (((lane >> 2) & 3) << 6) | (((lane >> 4) & 1) << 5) | (((lane >> 5) & 1) << 8); }
constexpr int v_rd_off(int d0, int ks, int half) { return d0 * 512 + ks * 4096 + half * 2048; }
template <int OFF> __device__ __forceinline__ s16x4 tr_read(int vb) {
    s16x4 r; asm volatile("ds_read_b64_tr_b16 %0, %1 offset:%2" : "=&v"(r) : "v"(vb), "i"(OFF) : "memory"); return r;
}
template <int D0> __device__ __forceinline__ void pv_one(f32x16& od, int vb, bf16x8 pa0, bf16x8 pa1, bf16x8 pa2, bf16x8 pa3) {
    const s16x4 l0 = tr_read<v_rd_off(D0, 0, 0)>(vb), h0 = tr_read<v_rd_off(D0, 0, 1)>(vb), l1 = tr_read<v_rd_off(D0, 1, 0)>(vb), h1 = tr_read<v_rd_off(D0, 1, 1)>(vb);
    const s16x4 l2 = tr_read<v_rd_off(D0, 2, 0)>(vb), h2 = tr_read<v_rd_off(D0, 2, 1)>(vb), l3 = tr_read<v_rd_off(D0, 3, 0)>(vb), h3 = tr_read<v_rd_off(D0, 3, 1)>(vb);
    asm volatile("s_waitcnt lgkmcnt(0)" ::: "memory"); SBAR();
#define PKV(L, H) (bf16x8){L[0], L[1], L[2], L[3], H[0], H[1], H[2], H[3]}
    od = __builtin_amdgcn_mfma_f32_32x32x16_bf16(PKV(l0, h0), pa0, od, 0, 0, 0);
    od = __builtin_amdgcn_mfma_f32_32x32x16_bf16(PKV(l1, h1), pa1, od, 0, 0, 0);
    od = __builtin_amdgcn_mfma_f32_32x32x16_bf16(PKV(l2, h2), pa2, od, 0, 0, 0);
    od = __builtin_amdgcn_mfma_f32_32x32x16_bf16(PKV(l3, h3), pa3, od, 0, 0, 0);
#undef PKV
}
__device__ __forceinline__ void pv_d0(f32x16* o, int vb, bf16x8 pa0, bf16x8 pa1, bf16x8 pa2, bf16x8 pa3) {
    pv_one<0>(o[0], vb, pa0, pa1, pa2, pa3); pv_one<1>(o[1], vb, pa0, pa1, pa2, pa3); pv_one<2>(o[2], vb, pa0, pa1, pa2, pa3); pv_one<3>(o[3], vb, pa0, pa1, pa2, pa3);
}

template <int MLA>
__device__ __forceinline__ void attn_unit(const bf16* __restrict__ Qn, const bf16* __restrict__ Qr, int ldq, const bf16* __restrict__ Kn, const bf16* __restrict__ Vn, int ldk,
                                          const bf16* __restrict__ Kr, bf16* __restrict__ O, int ldo, int seq, const float SCALE, char* lds) {
    constexpr int NQL = MLA ? MLA_NQL : 0, SD = MLA ? MLA_SD : 2;
    const int tid = threadIdx.x, wid = tid >> 6, lane = tid & 63, r32 = lane & 31, hi = lane >> 5;
    char* V_lds = lds + OFF_V; char* K_lds = lds + OFF_K; char* KR_lds = lds + OFF_KR;
    float m_reg = -1e30f, l_reg = 0; f32x16 o[4] = {}; bf16x8 qr[NQL < 8 ? 8 - NQL : 1];
    char* qrl = lds + OFF_QR + wid * 8192 + lane * 16;
    const bf16* Qw = Qn + (long)(wid * QBLK + r32) * ldq + hi * 8;
#pragma unroll
    for (int d0 = 0; d0 < 8; ++d0) { if (d0 < NQL) *(bf16x8*)(qrl + (4 + d0) * 1024) = ld8(Qw + d0 * 16); else qr[d0 - NQL] = ld8(Qw + d0 * 16); }
    if constexpr (MLA) { const bf16* Qx = Qr + (long)(wid * QBLK + r32) * ldq + hi * 8;
        *(bf16x8*)(qrl) = ld8(Qx); *(bf16x8*)(qrl + 1024) = ld8(Qx + 16); *(bf16x8*)(qrl + 2048) = ld8(Qx + 128); *(bf16x8*)(qrl + 3072) = ld8(Qx + 144); }
    const int sr = tid >> 4, sc = (tid & 15) * 8, vst0 = v_st(sr, sc), vst1 = v_st(32 + sr, sc);
    const int krr = tid >> 3, krc = (tid & 7) * 8;
    const int vb0 = (int)(uintptr_t)V_lds + v_rd_base(lane);
    struct { bf16x8 vs0, vs1, ks0, ks1, kr; } sr_[SD];
#define SLOAD(i, k0) do { sr_[i].vs0 = ld8(&Vn[(long)((k0) + sr) * ldk + sc]); sr_[i].vs1 = ld8(&Vn[(long)((k0) + 32 + sr) * ldk + sc]); \
    sr_[i].ks0 = ld8(&Kn[(long)((k0) + sr) * ldk + sc]); sr_[i].ks1 = ld8(&Kn[(long)((k0) + 32 + sr) * ldk + sc]); \
    if constexpr (MLA) sr_[i].kr = ld8(&Kr[(long)((k0) + krr) * 64 + krc]); } while (0)
#define SWRITE(b, i) do { *(bf16x8*)(V_lds + (b) * SHM_V + vst0) = sr_[i].vs0; *(bf16x8*)(V_lds + (b) * SHM_V + vst1) = sr_[i].vs1; { const int kc = sc * 2; \
    *(bf16x8*)(K_lds + (b) * SHM_K + KSWZ(sr, kc)) = sr_[i].ks0; *(bf16x8*)(K_lds + (b) * SHM_K + KSWZ(32 + sr, kc)) = sr_[i].ks1; } \
    if constexpr (MLA) *(bf16x8*)(KR_lds + (b) * SHM_KR + KRSWZ(krr, krc * 2)) = sr_[i].kr; } while (0)
#define SWAIT() do { if constexpr (SD == 1) asm volatile("s_waitcnt vmcnt(0)" ::: "memory"); else if constexpr (MLA) asm volatile("s_waitcnt vmcnt(5)" ::: "memory"); else asm volatile("s_waitcnt vmcnt(4)" ::: "memory"); } while (0)
#define RESC(a) do { if (__any((a) < 1.f)) { _Pragma("unroll") for (int d = 0; d < 4; ++d) _Pragma("unroll") for (int r = 0; r < 16; ++r) o[d][r] *= (a); } } while (0)
    f32x16 pA0, pA1, pB0, pB1; float mnA, mnB, alA, alB; bf16x8 pa0, pa1, pa2, pa3; const int NT = seq / KVBLK;
    constexpr int SE = 0, SO = SD - 1;
    SLOAD(SE, 0); asm volatile("s_waitcnt vmcnt(0)" ::: "memory"); SWRITE(0, SE); __syncthreads();
    qkt<MLA>(pA0, pA1, K_lds, KR_lds, qr, qrl, r32, hi); partialSM(pA0, pA1, m_reg, mnA, alA, SCALE);
    SLOAD(SO, KVBLK); if constexpr (SD == 2) { if (2 < NT) SLOAD(SE, 2 * KVBLK); }
    SWAIT(); SWRITE(1, SO); __syncthreads();
    for (int j = 1; j + 1 < NT; j += 2) {
        SBAR(); qkt<MLA>(pB0, pB1, K_lds + SHM_K, KR_lds + SHM_KR, qr, qrl, r32, hi);
        finishSM(pA0, pA1, alA, l_reg, pa0, pa1, pa2, pa3); SBAR();
        SLOAD(SO, (j + SD) * KVBLK); SBAR();
        pv_d0(o, vb0, pa0, pa1, pa2, pa3); partialSM(pB0, pB1, m_reg, mnB, alB, SCALE);
        __syncthreads(); SWAIT(); SWRITE(0, SE);
        RESC(alB); __syncthreads();
        SBAR(); qkt<MLA>(pA0, pA1, K_lds, KR_lds, qr, qrl, r32, hi);
        finishSM(pB0, pB1, alB, l_reg, pa0, pa1, pa2, pa3); SBAR();
        if (SD == 1 || j + 3 < NT) SLOAD(SE, (j + 1 + SD) * KVBLK); SBAR();
        pv_d0(o, vb0 + SHM_V, pa0, pa1, pa2, pa3); partialSM(pA0, pA1, m_reg, mnA, alA, SCALE);
        __syncthreads(); SWAIT(); SWRITE(1, SO);
        RESC(alA); __syncthreads();
    }
    SBAR(); qkt<MLA>(pB0, pB1, K_lds + SHM_K, KR_lds + SHM_KR, qr, qrl, r32, hi);
    finishSM(pA0, pA1, alA, l_reg, pa0, pa1, pa2, pa3); SBAR();
    pv_d0(o, vb0, pa0, pa1, pa2, pa3); partialSM(pB0, pB1, m_reg, mnB, alB, SCALE);
    __syncthreads(); RESC(alB);
    finishSM(pB0, pB1, alB, l_reg, pa0, pa1, pa2, pa3); SBAR();
    pv_d0(o, vb0 + SHM_V, pa0, pa1, pa2, pa3);
    const float rl = __builtin_amdgcn_rcpf(l_reg);
    bf16* Ow = O + (long)(wid * QBLK + r32) * ldo + 4 * hi;
#pragma unroll
    for (int d0 = 0; d0 < 4; ++d0)
#pragma unroll
        for (int g = 0; g < 4; ++g) { u32x2 w; w.x = cvt_pk_bf16(o[d0][4 * g] * rl, o[d0][4 * g + 1] * rl); w.y = cvt_pk_bf16(o[d0][4 * g + 2] * rl, o[d0][4 * g + 3] * rl);
            *(u32x2*)(Ow + 32 * d0 + 8 * g) = w; }
    __syncthreads();
#undef SLOAD
#undef SWRITE
#undef SWAIT
#undef RESC
}
}
static_assert(att::LDS_ATT <= RING_BYTES, "attention LDS");

__device__ __forceinline__ void p4_attn0(const Ctx& C) {
    const bf16* proj = (const bf16*)(C.ws + WS_PROJ); bf16* mix = (bf16*)(C.ws + WS_MIX);
    const float scale = 0.08838834764831845f;
    for (int u = C.vcu; u < 512 + 32; u += C.G) {
        int b, h, row0, seq;
        if (u < 512) { const int pair = u >> 6, w = u & 63; b = pair >> 1; h = (pair & 1) * 4 + (w >> 4); row0 = b * RPB + CL + 256 * (w & 15); seq = RPB; }
        else { const int v = u - 512; b = v >> 3; h = v & 7; row0 = b * RPB; seq = CL; }
        const int kvh = h >> 2; const bf16* kb = proj + (size_t)b * RPB * A_IN;
        att::attn_unit<0>(proj + (size_t)row0 * A_IN + 3072 + 128 * h, nullptr, A_IN, kb + 4096 + 128 * kvh, kb + 4352 + 128 * kvh, A_IN, nullptr,
                          mix + (size_t)row0 * DM + 1024 + 128 * h, DM, seq, scale, (char*)C.lds);
    }
}

template <int L>
__device__ __forceinline__ void p_mixer_ln(const Ctx& C, const Args& a) {
    const float* mod = (const float*)(C.ws + WS_MOD) + (size_t)L * 5 * 12288; float* X = (float*)(C.ws + WS_X);
    const bf16* y1 = (const bf16*)(C.ws + (L == 0 ? WS_Y1_0 : WS_Y1_1)); bf16* U = (bf16*)(C.ws + WS_U); bf16* ULO = (bf16*)(C.ws + WS_ULO);
    const float* lng = a.in[I_LNG] + (size_t)(L * 2 + 0) * DM; const float* lnb = a.in[I_LNB] + (size_t)(L * 2 + 0) * DM;
    for (int r = C.gw; r < MROWS; r += C.ngw) {
        int b, p; row_info(r, b, p); const bool isctx = p < CL; if (L == 1 && isctx) continue;
        const float* mr = mod + (size_t)(isctx ? 4 : b) * 12288;
        const float* xo = (L == 0) ? in_row(a, b, p) : X + (size_t)r * DM;
        f32x4 t[8]; float s = 0.f;
#pragma unroll
        for (int j = 0; j < 8; ++j) { const int e = 4 * (C.lane + 64 * j); const f32x4 x = *(const f32x4*)(xo + e), g = *(const f32x4*)(mr + 4096 + e); const u32x2 yw = *(const u32x2*)(y1 + (size_t)r * DM + e);
            const f32x4 y = {bf_lo(yw.x), bf_hi(yw.x), bf_lo(yw.y), bf_hi(yw.y)}; t[j] = x * DN_ALPHA + g * y; s += (t[j][0] + t[j][1]) + (t[j][2] + t[j][3]); }
        const float mean = wave_sum(s) * (1.f / DM); float s2 = 0.f;
#pragma unroll
        for (int j = 0; j < 8; ++j) { t[j] = t[j] - mean; s2 += (t[j][0] * t[j][0] + t[j][1] * t[j][1]) + (t[j][2] * t[j][2] + t[j][3] * t[j][3]); }
        const float rstd = 1.f / sqrtf(wave_sum(s2) * (1.f / DM) + LN_EPS);
#pragma unroll
        for (int j = 0; j < 8; ++j) { const int e = 4 * (C.lane + 64 * j); const f32x4 xn = t[j] * rstd * *(const f32x4*)(lng + e) + *(const f32x4*)(lnb + e);
            *(f32x4*)(X + (size_t)r * DM + e) = xn;
            const f32x4 v = xn * (*(const f32x4*)(mr + 8192 + e) + 1.f) + *(const f32x4*)(mr + 6144 + e);
            u32x2 w; w.x = cvt_pk_bf16(v[0], v[1]); w.y = cvt_pk_bf16(v[2], v[3]); *(u32x2*)(U + (size_t)r * DM + e) = w;
            u32x2 l; l.x = cvt_pk_bf16(v[0] - bf_lo(w.x), v[1] - bf_hi(w.x)); l.y = cvt_pk_bf16(v[2] - bf_lo(w.y), v[3] - bf_hi(w.y)); *(u32x2*)(ULO + (size_t)r * DM + e) = l; }
    }
}

struct EpiLogits {
    float* O;
    __device__ __forceinline__ void operator()(const f32x4 (&acc)[2][2][4][2], const pg8::Unit& u, int wr, int wc, int fr, int fq) const {
        const int row0 = u.pm * 256 + wr * 64 + fr, col0 = wc * 32 + 8 * fq;
#pragma unroll
        for (int ai = 0; ai < 2; ++ai)
#pragma unroll
            for (int m = 0; m < 4; ++m) { float* rowp = O + (size_t)(row0 + ai * 128 + m * 16) * 128 + col0;
                *(f32x4*)(rowp) = acc[ai][0][m][0]; *(f32x4*)(rowp + 4) = acc[ai][0][m][1]; }
    }
};

template <int L>
__device__ __forceinline__ void p_route(const Ctx& C, const Args& a) {
    const float* LOG = (const float*)(C.ws + WS_LOG); int* TE = (int*)(C.ws + WS_TE); float* TW = (float*)(C.ws + WS_TW); int* INV = (int*)(C.ws + WS_INV);
    LAS int* hist = (LAS int*)C.lds; LAS int* base = hist + 64; LAS int* rec = hist + 128;
    if (C.tid < 128) hist[C.tid] = 0;
    __syncthreads();
    const float rb = a.in[I_RB][L * NE + C.lane];
    const float NINF = -__builtin_inff();
    int it = 0;
    for (int r = C.gw; r < MROWS; r += C.ngw, ++it) {
        int b, p; row_info(r, b, p); if (L == 1 && p < CL) continue;
        const float lg = (LOG[(size_t)r * 128 + C.lane] + LOG[(size_t)r * 128 + 64 + C.lane]) + (LOG[(size_t)(MROWS + r) * 128 + C.lane] + LOG[(size_t)(MROWS + r) * 128 + 64 + C.lane]);
        const float sc = 1.f / (1.f + __expf(-lg));
        const float sel = sc + rb;
        float m1 = sel; m1 = fmaxf(m1, __shfl_xor(m1, 1)); m1 = fmaxf(m1, __shfl_xor(m1, 2)); m1 = fmaxf(m1, __shfl_xor(m1, 4));
        const unsigned long long eq = __ballot(sel == m1); const int g = C.lane >> 3;
        const unsigned gm = (unsigned)(eq >> (8 * g)) & 0xFFu; const int first = 8 * g + (__ffs(gm) - 1);
        float m2 = (C.lane == first) ? NINF : sel; m2 = fmaxf(m2, __shfl_xor(m2, 1)); m2 = fmaxf(m2, __shfl_xor(m2, 2)); m2 = fmaxf(m2, __shfl_xor(m2, 4));
        const float gs = m1 + m2;
        int grank = 0;
#pragma unroll
        for (int q = 0; q < 8; ++q) { const float o = __shfl(gs, 8 * q); grank += (o > gs || (o == gs && q < g)) ? 1 : 0; }
        const bool gsel = grank < 4;
        const float ms = gsel ? sel : NINF;
        int rank = 0;
#pragma unroll
        for (int q = 0; q < 64; ++q) { const float o = __shfl(ms, q); rank += (o > ms || (o == ms && q < C.lane)) ? 1 : 0; }
        const bool chosen = gsel && rank < 6;
        const float wsum = wave_sum(chosen ? sc : 0.f);
        if (chosen) {
            const int lr = atomicAdd((int*)&hist[C.lane], 1);
            rec[((C.wave * 12 + it) * 8 + rank) * 2] = C.lane; rec[((C.wave * 12 + it) * 8 + rank) * 2 + 1] = lr;
            TW[(size_t)r * 8 + rank] = sc / wsum * 2.5f;
        }
    }
    __syncthreads();
    if (C.tid < 64) { const int h = hist[C.tid]; base[C.tid] = h ? (int)__hip_atomic_fetch_add(C.ctl + CW_CNT + L * 64 + C.tid, (unsigned)h, RLX_AGENT) : 0; }
    __syncthreads();
    it = 0;
    for (int r = C.gw; r < MROWS; r += C.ngw, ++it) {
        int b, p; row_info(r, b, p); if (L == 1 && p < CL) continue;
        if (C.lane < 6) { const int e = rec[((C.wave * 12 + it) * 8 + C.lane) * 2], lr = rec[((C.wave * 12 + it) * 8 + C.lane) * 2 + 1];
            TE[(size_t)r * 8 + C.lane] = e; INV[(size_t)r * 8 + C.lane] = lr + base[e]; }
    }
    __syncthreads();
}

template <int L>
__device__ __forceinline__ void p_dispatch(const Ctx& C) {
    const int* TE = (const int*)(C.ws + WS_TE); int* INV = (int*)(C.ws + WS_INV); int* BLKE = (int*)(C.ws + WS_BLKE);
    const bf16* U = (const bf16*)(C.ws + WS_U); bf16* XS = (bf16*)(C.ws + WS_XS);
    LAS int* pstart = (LAS int*)C.lds;
    if (C.tid == 0) { int acc = 0; for (int e = 0; e < NE; ++e) { const int c = (int)__hip_atomic_load(C.ctl + CW_CNT + L * 64 + e, RLX_AGENT); pstart[e] = acc; const int nb = (c + 255) >> 8;
            if (C.bid == 0) for (int q = 0; q < nb; ++q) BLKE[(acc >> 8) + q] = e;
            acc += nb << 8; }
        pstart[NE] = acc; if (C.bid == 0) C.ctl[CW_NBLK + L] = (unsigned)(acc >> 8); }
    __syncthreads();
    for (int r = C.gw; r < MROWS; r += C.ngw) {
        int b, p; row_info(r, b, p); if (L == 1 && p < CL) continue;
        int slot = 0;
        if (C.lane < 6) { const int e = TE[(size_t)r * 8 + C.lane]; slot = pstart[e] + INV[(size_t)r * 8 + C.lane]; INV[(size_t)r * 8 + C.lane] = slot; }
        u32x4 v[4];
#pragma unroll
        for (int j = 0; j < 4; ++j) v[j] = *(const u32x4*)(U + (size_t)r * DM + 8 * (C.lane + 64 * j));
#pragma unroll
        for (int k = 0; k < 6; ++k) { const int s = __shfl(slot, k);
#pragma unroll
            for (int j = 0; j < 4; ++j) *(u32x4*)(XS + (size_t)s * DM + 8 * (C.lane + 64 * j)) = v[j]; }
    }
    __syncthreads();
}

__device__ __forceinline__ int nblk_ld(const Ctx& C, int L) { const int n = (int)__hip_atomic_load(C.ctl + CW_NBLK + L, RLX_AGENT); return n < XS_BLK ? n : XS_BLK; }
struct MoeSched {
    const int* blke; int nblk_r, nsh, ncol, G, c, sh_lat_only;
    __device__ __forceinline__ bool next(int i, pg8::Unit& u) const {
        const int total = (nblk_r + nsh) * ncol; const long Lq = (long)i * G + c; if (Lq >= total) return false;
        const int w = pg8::xcd_remap((int)Lq, total); const int b = w / ncol, j = w - b * ncol;
        int e, pm;
        if (b < nblk_r) { pm = b; e = (int)__hip_atomic_load((const unsigned*)blke + b, RLX_AGENT) & 63; } else { int sb = b - nblk_r; if (sh_lat_only) sb = 17 * (sb >> 4) + 1 + (sb & 15); pm = XS_BLK + sb; e = NE; }
        u.pm = pm; u.pn = e * ncol + j; return true;
    }
};
struct EpiSwiGLU {
    bf16* H;
    __device__ __forceinline__ void operator()(const f32x4 (&acc)[2][2][4][2], const pg8::Unit& u, int wr, int wc, int fr, int fq) const {
        const int row0 = u.pm * 256 + wr * 64 + fr, col0 = (u.pn & 3) * 128 + wc * 32 + 8 * fq;
#pragma unroll
        for (int ai = 0; ai < 2; ++ai)
#pragma unroll
            for (int m = 0; m < 4; ++m) { float h[8];
#pragma unroll
                for (int n = 0; n < 2; ++n)
#pragma unroll
                    for (int i = 0; i < 4; ++i) { const float g = acc[ai][0][m][n][i], up = acc[ai][1][m][n][i]; h[4 * n + i] = g * __builtin_amdgcn_rcpf(1.f + __expf(-g)) * up; }
                u32x4 w; w.x = cvt_pk_bf16(h[0], h[1]); w.y = cvt_pk_bf16(h[2], h[3]); w.z = cvt_pk_bf16(h[4], h[5]); w.w = cvt_pk_bf16(h[6], h[7]);
                *(u32x4*)(H + (size_t)(row0 + ai * 128 + m * 16) * FF + col0) = w; }
    }
};
struct EpiDown {
    bf16* Y;
    __device__ __forceinline__ void operator()(const f32x4 (&acc)[2][2][4][2], const pg8::Unit& u, int wr, int wc, int fr, int fq) const {
        const int row0 = u.pm * 256 + wr * 64 + fr, col0 = (u.pn & 7) * 256 + wc * 32 + 8 * fq;
#pragma unroll
        for (int ai = 0; ai < 2; ++ai)
#pragma unroll
            for (int m = 0; m < 4; ++m) { bf16* rowp = Y + (size_t)(row0 + ai * 128 + m * 16) * DM + col0;
#pragma unroll
                for (int bj = 0; bj < 2; ++bj) { const f32x4 v0 = acc[ai][bj][m][0], v1 = acc[ai][bj][m][1];
                    u32x4 w; w.x = cvt_pk_bf16(v0[0], v0[1]); w.y = cvt_pk_bf16(v0[2], v0[3]); w.z = cvt_pk_bf16(v1[0], v1[1]); w.w = cvt_pk_bf16(v1[2], v1[3]);
                    *(u32x4*)(rowp + bj * 128) = w; } }
    }
};

template <int L>
__device__ __forceinline__ void p_combine(const Ctx& C, const Args& a) {
    const float* mod = (const float*)(C.ws + WS_MOD) + (size_t)L * 5 * 12288; float* X = (float*)(C.ws + WS_X);
    const bf16* Y = (const bf16*)(C.ws + WS_Y); const int* INV = (const int*)(C.ws + WS_INV); const float* TW = (const float*)(C.ws + WS_TW);
    bf16* UM = (bf16*)(C.ws + WS_UM);
    const float* lng = a.in[I_LNG] + (size_t)(L * 2 + 1) * DM; const float* lnb = a.in[I_LNB] + (size_t)(L * 2 + 1) * DM;
    for (int r = C.gw; r < MROWS; r += C.ngw) {
        int b, p; row_info(r, b, p); const bool isctx = p < CL; if (L == 1 && isctx) continue;
        const float* mr = mod + (size_t)(isctx ? 4 : b) * 12288;
        int slot = 0; float wt = 0.f;
        if (C.lane < 6) { slot = INV[(size_t)r * 8 + C.lane]; wt = TW[(size_t)r * 8 + C.lane]; }
        f32x4 f[8];
        { const bf16* ys = Y + ((size_t)XS_BLK * 256 + r) * DM;
#pragma unroll
          for (int j = 0; j < 8; ++j) { const u32x2 yw = *(const u32x2*)(ys + 4 * (C.lane + 64 * j)); f[j] = (f32x4){bf_lo(yw.x), bf_hi(yw.x), bf_lo(yw.y), bf_hi(yw.y)}; } }
#pragma unroll
        for (int k = 0; k < 6; ++k) { const int s = __shfl(slot, k); const float w = __shfl(wt, k); const bf16* ys = Y + (size_t)s * DM;
#pragma unroll
            for (int j = 0; j < 8; ++j) { const u32x2 yw = *(const u32x2*)(ys + 4 * (C.lane + 64 * j)); f[j] += (f32x4){bf_lo(yw.x), bf_hi(yw.x), bf_lo(yw.y), bf_hi(yw.y)} * w; } }
        float s = 0.f;
#pragma unroll
        for (int j = 0; j < 8; ++j) { const int e = 4 * (C.lane + 64 * j); f[j] = *(const f32x4*)(X + (size_t)r * DM + e) * DN_ALPHA + *(const f32x4*)(mr + 10240 + e) * f[j]; s += (f[j][0] + f[j][1]) + (f[j][2] + f[j][3]); }
        const float mean = wave_sum(s) * (1.f / DM); float s2 = 0.f;
#pragma unroll
        for (int j = 0; j < 8; ++j) { f[j] = f[j] - mean; s2 += (f[j][0] * f[j][0] + f[j][1] * f[j][1]) + (f[j][2] * f[j][2] + f[j][3] * f[j][3]); }
        const float rstd = 1.f / sqrtf(wave_sum(s2) * (1.f / DM) + LN_EPS);
        float* orow = (L == 0) ? X + (size_t)r * DM : a.out + ((size_t)(b * SEQ + (p - CL))) * DM;
        const float* mn = mod + (size_t)5 * 12288 + (size_t)(isctx ? 4 : b) * 12288;
#pragma unroll
        for (int j = 0; j < 8; ++j) { const int e = 4 * (C.lane + 64 * j); const f32x4 xn = f[j] * rstd * *(const f32x4*)(lng + e) + *(const f32x4*)(lnb + e);
            *(f32x4*)(orow + e) = xn;
            if (L == 0) { const f32x4 v = xn * (*(const f32x4*)(mn + 2048 + e) + 1.f) + *(const f32x4*)(mn + e);
                u32x2 w; w.x = cvt_pk_bf16(v[0], v[1]); w.y = cvt_pk_bf16(v[2], v[3]); *(u32x2*)(UM + (size_t)r * DM + e) = w; } }
    }
}

__device__ __forceinline__ void p13_mla_norm(const Ctx& C, const Args& a) {
    const bf16* dp = (const bf16*)(C.ws + WS_DOWNP); bf16* cq = (bf16*)(C.ws + WS_CQKV); bf16* ckv = cq + (size_t)MROWS * 512; bf16* kr = (bf16*)(C.ws + WS_KR);
    const f32x2* rope = (const f32x2*)(C.ws + WS_ROPE64);
    const f32x4 qga = *(const f32x4*)(a.in[I_MQG] + 8 * C.lane), qgb = *(const f32x4*)(a.in[I_MQG] + 8 * C.lane + 4);
    const f32x4 kga = *(const f32x4*)(a.in[I_MKVG] + 8 * C.lane), kgb = *(const f32x4*)(a.in[I_MKVG] + 8 * C.lane + 4);
    for (int r = C.gw; r < MROWS; r += C.ngw) {
        int b, p; row_info(r, b, p); const bool isctx = p < CL;
        const bf16* row = dp + (size_t)r * 1280;
#pragma unroll
        for (int part = 0; part < 2; ++part) {
            const u32x4 w = *(const u32x4*)(row + 512 * part + 8 * C.lane);
            float v[8] = {bf_lo(w.x), bf_hi(w.x), bf_lo(w.y), bf_hi(w.y), bf_lo(w.z), bf_hi(w.z), bf_lo(w.w), bf_hi(w.w)};
            float ss = 0.f;
#pragma unroll
            for (int q = 0; q < 8; ++q) ss += v[q] * v[q];
            const float rs = 1.f / sqrtf(wave_sum(ss) * (1.f / 512.f) + RMS_EPS);
            const f32x4 ga = part ? kga : qga, gb = part ? kgb : qgb;
            u32x4 o; o.x = cvt_pk_bf16(v[0] * rs * ga[0], v[1] * rs * ga[1]); o.y = cvt_pk_bf16(v[2] * rs * ga[2], v[3] * rs * ga[3]);
            o.z = cvt_pk_bf16(v[4] * rs * gb[0], v[5] * rs * gb[1]); o.w = cvt_pk_bf16(v[6] * rs * gb[2], v[7] * rs * gb[3]);
            *(u32x4*)((part ? ckv : cq) + (size_t)r * 512 + 8 * C.lane) = o;
        }
        if (C.lane < 32) { const float x1 = bf2f(row[1024 + C.lane]), x2 = bf2f(row[1056 + C.lane]);
            f32x2 cs = {1.f, 0.f}; if (!isctx) cs = rope[(size_t)(p - CL) * 32 + C.lane];
            kr[(size_t)r * 64 + C.lane] = (bf16)f2bf(x1 * cs.x - x2 * cs.y); kr[(size_t)r * 64 + 32 + C.lane] = (bf16)f2bf(x2 * cs.x + x1 * cs.y); }
    }
}

struct UpSched {
    int G, c;
    __device__ __forceinline__ bool next(int i, pg8::Unit& u) const {
        constexpr int NQ = 64 * 12, NKV = MT * 16; const long Lq = (long)i * G + c; if (Lq >= NQ + NKV) return false;
        const int w = pg8::xcd_remap((int)Lq, NQ + NKV); int pm, pn;
        if (w < NQ) { pg8::tile_of(w, 64, 12, pm, pn); pm = 17 * (pm >> 4) + 1 + (pm & 15); }
        else { pg8::tile_of(w - NQ, MT, 16, pm, pn); pm += MT; pn += 12; }
        u.pm = pm; u.pn = pn; return true;
    }
};
struct EpiUp {
    bf16* QB; bf16* KVB; const f32x2* rope;
    __device__ __forceinline__ void operator()(const f32x4 (&acc)[2][2][4][2], const pg8::Unit& u, int wr, int wc, int fr, int fq) const {
        const bool isq = u.pn < 12; const int rowt = isq ? u.pm : u.pm - MT;
        const int row0 = rowt * 256 + wr * 64 + fr, cw = wc * 32 + 8 * fq;
        bf16* base = isq ? QB + 256 * u.pn + cw : KVB + 256 * (u.pn - 12) + cw; const int ldc = isq ? 3072 : 4096;
        const bool dorope = isq && u.pn >= 8;
#pragma unroll
        for (int ai = 0; ai < 2; ++ai)
#pragma unroll
            for (int m = 0; m < 4; ++m) { const int row = row0 + ai * 128 + m * 16; bf16* rowp = base + (size_t)row * ldc;
                f32x4 a0 = acc[ai][0][m][0], a1 = acc[ai][0][m][1], b0 = acc[ai][1][m][0], b1 = acc[ai][1][m][1];
                if (dorope) { const int bb = row / RPB, pos = row - bb * RPB - CL; const f32x2* rp = rope + (size_t)pos * 32 + 8 * fq;
#pragma unroll
                    for (int i = 0; i < 4; ++i) { const f32x2 c0 = rp[i], c1 = rp[4 + i];
                        const float x1 = a0[i], x2 = b0[i]; a0[i] = x1 * c0.x - x2 * c0.y; b0[i] = x2 * c0.x + x1 * c0.y;
                        const float y1 = a1[i], y2 = b1[i]; a1[i] = y1 * c1.x - y2 * c1.y; b1[i] = y2 * c1.x + y1 * c1.y; } }
                u32x4 w; w.x = cvt_pk_bf16(a0[0], a0[1]); w.y = cvt_pk_bf16(a0[2], a0[3]); w.z = cvt_pk_bf16(a1[0], a1[1]); w.w = cvt_pk_bf16(a1[2], a1[3]);
                *(u32x4*)(rowp) = w;
                w.x = cvt_pk_bf16(b0[0], b0[1]); w.y = cvt_pk_bf16(b0[2], b0[3]); w.z = cvt_pk_bf16(b1[0], b1[1]); w.w = cvt_pk_bf16(b1[2], b1[3]);
                *(u32x4*)(rowp + 128) = w; }
    }
};

__device__ __forceinline__ void p15_attn1(const Ctx& C) {
    const bf16* qb = (const bf16*)(C.ws + WS_QB); const bf16* kvb = (const bf16*)(C.ws + WS_KVB); const bf16* kr = (const bf16*)(C.ws + WS_KR); bf16* attb = (bf16*)(C.ws + WS_ATT);
    const float scale = 0.07216878364870323f;
    for (int u = C.vcu; u < 1024; u += C.G) {
        const int bh = u >> 4, qblk = u & 15, b = bh >> 4, h = bh & 15, row0 = b * RPB + CL + 256 * qblk;
        const bf16* kn = kvb + (size_t)b * RPB * 4096 + 256 * h;
        att::attn_unit<1>(qb + (size_t)row0 * 3072 + 128 * h, qb + (size_t)row0 * 3072 + 2048 + 256 * (h >> 2) + 32 * (h & 3), 3072, kn, kn + 128, 4096, kr + (size_t)b * RPB * 64,
                          attb + (size_t)row0 * DM + 128 * h, DM, RPB, scale, (char*)C.lds);
    }
}

constexpr int NPH = 24;
__global__ void __launch_bounds__(512, 2) fwd(Args args) {
    extern __shared__ __attribute__((aligned(16))) unsigned char lds_raw[];
    Ctx C;
    C.lds = (LAS unsigned char*)lds_raw;
    C.tid = threadIdx.x; C.lane = C.tid & 63; C.wave = __builtin_amdgcn_readfirstlane(C.tid >> 6);
    C.G = gridDim.x; C.bid = blockIdx.x; C.vcu = (C.G % 8 == 0) ? (C.bid % 8) * (C.G / 8) + C.bid / 8 : C.bid;
    C.gw = C.bid * 8 + C.wave; C.ngw = C.G * 8;
    C.ws = args.ws; C.ctl = (unsigned*)(args.ws + WS_CTL);
    volatile LAS unsigned* MISC = (volatile LAS unsigned*)(C.lds + MISC_OFF);
    for (int u = C.tid; u < (LDS_BYTES - RING_BYTES) / 4; u += 512) ((LAS unsigned*)(C.lds + RING_BYTES))[u] = 0u;
    __syncthreads();
    XcdBarrier bar; bar.bar = C.ctl + CW_BAR; bar.x = 0; bar.st = nullptr;
    if (!MK_PER_PHASE) bar = xcd_barrier_post(C.ctl + CW_BAR, MISC + 8);
    const int lo = args.ph_lo, hi = args.ph_hi;
    unsigned char* ws = C.ws;
#ifndef PHMASK
#define PHMASK 0xFFFFFFFFu
#endif
#define IN(k) (((PHMASK >> (k)) & 1u) && lo <= (k) && (k) < hi)
#define SEAM(k) do { if (IN(k) && IN((k) + 1)) xcd_barrier(bar); } while (0)

    if (IN(0)) p0_prologue(C, args);
    SEAM(0);
    if (IN(1)) p1_modulate0(C, args);
    SEAM(1);
    if (IN(2)) {
        pg8::Gemm g{(const bf16*)(ws + WS_UM), (const bf16*)(ws + WS_W_IN), DM}; DenseSched S{MT, A_IN / 256, C.G, C.bid, 0, 0, 0};
        EpiStoreBf16 E{(bf16*)(ws + WS_PROJ), A_IN}; pg8::gemm_phase(C.lds, g, S, E);
    }
    SEAM(2);
    if (IN(3)) p3_qk_conv(C, args);
    SEAM(3);
    if (IN(4)) p4_attn0(C);
    SEAM(4);
    if (IN(5)) {
        pg8::Gemm g{(const bf16*)(ws + WS_MIX), (const bf16*)(ws + WS_W_OUT0), DM}; DenseSched S{MT, DM / 256, C.G, C.bid, 0, 0, 0};
        EpiStoreBf16 E{(bf16*)(ws + WS_Y1_0), DM}; pg8::gemm_phase(C.lds, g, S, E);
    }
    SEAM(5);
    if (IN(6)) p_mixer_ln<0>(C, args);
    SEAM(6);
    if (IN(7)) {
        pg8::Gemm g{(const bf16*)(ws + WS_U), (const bf16*)(ws + WS_W_RT), DM}; DenseSched S{2 * MT, 1, C.G, C.bid, 0, 0, 0};
        EpiLogits E{(float*)(ws + WS_LOG)}; pg8::gemm_phase(C.lds, g, S, E);
    }
    SEAM(7);
    if (IN(8)) p_route<0>(C, args);
    SEAM(8);
    if (IN(9)) p_dispatch<0>(C);
    SEAM(9);
    if (IN(10)) {
        pg8::Gemm g{(const bf16*)(ws + WS_XS), (const bf16*)(ws + WS_W_GU), DM};
        MoeSched S{(const int*)(ws + WS_BLKE), nblk_ld(C, 0), SH_BLK, 4, C.G, C.bid, 0};
        EpiSwiGLU E{(bf16*)(ws + WS_H)}; pg8::gemm_phase(C.lds, g, S, E);
    }
    SEAM(10);
    if (IN(11)) {
        pg8::Gemm g{(const bf16*)(ws + WS_H), (const bf16*)(ws + WS_W_D), FF};
        MoeSched S{(const int*)(ws + WS_BLKE), nblk_ld(C, 0), SH_BLK, 8, C.G, C.bid, 0};
        EpiDown E{(bf16*)(ws + WS_Y)}; pg8::gemm_phase(C.lds, g, S, E);
    }
    SEAM(11);
    if (IN(12)) p_combine<0>(C, args);
    SEAM(12);
    if (IN(13)) {
        pg8::Gemm g{(const bf16*)(ws + WS_UM), (const bf16*)(ws + WS_W_DOWN), DM}; DenseSched S{MT, 5, C.G, C.bid, 0, 0, 0};
        EpiStoreBf16 E{(bf16*)(ws + WS_DOWNP), 1280}; pg8::gemm_phase(C.lds, g, S, E);
    }
    SEAM(13);
    if (IN(14)) p13_mla_norm(C, args);
    SEAM(14);
    if (IN(15)) {
        pg8::Gemm g{(const bf16*)(ws + WS_CQKV), (const bf16*)(ws + WS_W_UQKV), 512}; UpSched S{C.G, C.bid};
        EpiUp E{(bf16*)(ws + WS_QB), (bf16*)(ws + WS_KVB), (const f32x2*)(ws + WS_ROPE64)}; pg8::gemm_phase(C.lds, g, S, E);
    }
    SEAM(15);
    if (IN(16)) p15_attn1(C);
    SEAM(16);
    if (IN(17)) {
        pg8::Gemm g{(const bf16*)(ws + WS_ATT), (const bf16*)(ws + WS_W_OUT1), DM}; DenseSched S{64, DM / 256, C.G, C.bid, 1, 0, 0};
        EpiStoreBf16 E{(bf16*)(ws + WS_Y1_1), DM}; pg8::gemm_phase(C.lds, g, S, E);
    }
    SEAM(17);
    if (IN(18)) p_mixer_ln<1>(C, args);
    SEAM(18);
    if (IN(19)) {
        pg8::Gemm g{(const bf16*)(ws + WS_U), (const bf16*)(ws + WS_W_RT + (size_t)256 * DM * 2), DM}; DenseSched S{2 * MT, 1, C.G, C.bid, 0, 0, 0};
        EpiLogits E{(float*)(ws + WS_LOG)}; pg8::gemm_phase(C.lds, g, S, E);
    }
    SEAM(19);
    if (IN(20)) p_route<1>(C, args);
    SEAM(20);
    if (IN(21)) p_dispatch<1>(C);
    SEAM(21);
    if (IN(22)) {
        pg8::Gemm g{(const bf16*)(ws + WS_XS), (const bf16*)(ws + WS_W_GU) + W_GU_L, DM};
        MoeSched S{(const int*)(ws + WS_BLKE), nblk_ld(C, 1), 64, 4, C.G, C.bid, 1};
        EpiSwiGLU E{(bf16*)(ws + WS_H)}; pg8::gemm_phase(C.lds, g, S, E);
    }
    SEAM(22);
    if (IN(23)) {
        pg8::Gemm g{(const bf16*)(ws + WS_H), (const bf16*)(ws + WS_W_D) + W_D_L, FF};
        MoeSched S{(const int*)(ws + WS_BLKE), nblk_ld(C, 1), 64, 8, C.G, C.bid, 1};
        EpiDown E{(bf16*)(ws + WS_Y)}; pg8::gemm_phase(C.lds, g, S, E);
    }
    SEAM(23);
    if (IN(24)) p_combine<1>(C, args);
#undef IN
#undef SEAM
}

extern "C" void kernel_launch(void* const* d_in, const int* in_sizes, int n_in, void* d_out, int out_size, void* d_ws, size_t ws_size, hipStream_t stream) {
    static int grid = 0;
    if (grid == 0) {
        if (n_in != 27 || ws_size < WS_END) { fprintf(stderr, "kernel_launch: n_in %d ws %zu (need %zu)\n", n_in, ws_size, (size_t)WS_END); grid = -1; return; }
        int dev = 0, cus = 0, per_cu = 0;
        if (hipGetDevice(&dev) != hipSuccess || hipDeviceGetAttribute(&cus, hipDeviceAttributeMultiprocessorCount, dev) != hipSuccess) { grid = -1; return; }
        if (hipFuncSetAttribute((const void*)fwd, hipFuncAttributeMaxDynamicSharedMemorySize, LDS_BYTES) != hipSuccess) { fprintf(stderr, "kernel_launch: hipFuncSetAttribute failed\n"); grid = -1; return; }
        if (hipOccupancyMaxActiveBlocksPerMultiprocessor(&per_cu, (const void*)fwd, 512, LDS_BYTES) != hipSuccess || per_cu < 1) fprintf(stderr, "kernel_launch: occupancy query says %d\n", per_cu);
        (void)hipGetLastError();
        grid = cus;
    }
    if (grid < 0) return;
    if (hipMemsetAsync((char*)d_ws + WS_CTL, 0, CTL_ZERO_BYTES, stream) != hipSuccess) return;
    Args a{};
    for (int i = 0; i < 27; ++i) a.in[i] = (const float*)d_in[i];
    a.out = (float*)d_out; a.ws = (unsigned char*)d_ws;
#if MK_PER_PHASE
    for (int k = 0; k <= NPH; ++k) { a.ph_lo = k; a.ph_hi = k + 1; hipLaunchKernelGGL(fwd, dim3(grid), dim3(512), LDS_BYTES, stream, a); }
#else
    a.ph_lo = 0; a.ph_hi = NPH + 1;
    hipLaunchKernelGGL(fwd, dim3(grid), dim3(512), LDS_BYTES, stream, a);
#endif
    const hipError_t le = hipPeekAtLastError();
    if (le != hipSuccess) fprintf(stderr, "kernel_launch: launch failed: %s\n", hipGetErrorName(le));
}
```

```cpp
#include <hip/hip_runtime.h>
#include <cstdio>
#include <cstdint>

#ifndef MK_PER_PHASE
#define MK_PER_PHASE 0
#endif

#define GAS __attribute__((address_space(1)))
#define LAS __attribute__((address_space(3)))
typedef unsigned short bf16;
typedef short bf16x8 __attribute__((ext_vector_type(8)));
typedef short s16x4 __attribute__((ext_vector_type(4)));
typedef float f32x4 __attribute__((ext_vector_type(4)));
typedef float f32x2 __attribute__((ext_vector_type(2)));
typedef float f32x16 __attribute__((ext_vector_type(16)));
typedef unsigned u32x4 __attribute__((ext_vector_type(4)));
typedef unsigned u32x2 __attribute__((ext_vector_type(2)));
#define RLX_AGENT __ATOMIC_RELAXED, __HIP_MEMORY_SCOPE_AGENT
#define LDS_WAIT() asm volatile("s_waitcnt lgkmcnt(0)" ::: "memory")
#define SBAR() __builtin_amdgcn_sched_barrier(0)

__device__ __forceinline__ unsigned cvt_pk_bf16(float lo, float hi) { unsigned r; asm volatile("v_cvt_pk_bf16_f32 %0, %1, %2" : "=v"(r) : "v"(lo), "v"(hi)); return r; }
__device__ __forceinline__ float bf_lo(unsigned w) { return __uint_as_float(w << 16); }
__device__ __forceinline__ float bf_hi(unsigned w) { return __uint_as_float(w & 0xffff0000u); }
__device__ __forceinline__ float bf2f(bf16 v) { return __uint_as_float(((unsigned)v) << 16); }
__device__ __forceinline__ unsigned f2bf(float f) { unsigned u = __float_as_uint(f); return (u + 0x7fffu + ((u >> 16) & 1u)) >> 16; }
__device__ __forceinline__ float wave_sum(float v) {
#pragma unroll
    for (int o = 1; o < 64; o <<= 1) v += __shfl_xor(v, o);
    return v;
}

namespace pg8 {
constexpr int BM = 256, BK = 64, HALF = 128, HTB = HALF * BK * 2, STAGE_BYTES = 8 * HTB, NXCD = 8, WGM = 8;
__host__ __device__ __forceinline__ int lds_byte(int r, int c) { const int st = (r >> 4) * 2 + (c >> 5), rr = r & 15, cc = c & 31, ob = rr * 64 + cc * 2; return st * 1024 + (ob ^ (((ob >> 9) & 1) << 5)); }
__host__ __device__ __forceinline__ void stage_rc(int b, int& R, int& C) { const int st = b / 1024, sb = b % 1024, swz = sb ^ (((sb >> 9) & 1) << 5); R = (st >> 1) * 16 + swz / 64; C = (st & 1) * 32 + (swz % 64) / 2; }
__host__ __device__ __forceinline__ int perm32(int rho) { const int n = rho >> 4, i = rho & 15; return 8 * (i >> 2) + 4 * n + (i & 3); }

struct Unit { int pm, pn; };
struct Gemm { const bf16* A; const bf16* Bt; int K; };

__device__ __forceinline__ int xcd_remap(int wgid, int nwg) { const int q = nwg / NXCD, r = nwg % NXCD, xcd = wgid % NXCD, off = wgid / NXCD; return (xcd < r ? xcd * (q + 1) : r * (q + 1) + (xcd - r) * q) + off; }
__device__ __forceinline__ void tile_of(int wgid, int nM, int nN, int& pm, int& pn) {
    const int nig = WGM * nN, gid = wgid / nig, fm = gid * WGM, gsz = (nM - fm) < WGM ? (nM - fm) : WGM;
    pm = fm + ((wgid % nig) % gsz); pn = (wgid % nig) / gsz;
}

template <class Epi, class Sched, bool ALIGN_EPI = true, bool SP2 = true>
__device__ __forceinline__ void gemm_phase(LAS unsigned char* lds, const Gemm g, const Sched& S, const Epi& E) {
    const int tid = threadIdx.x, wid = __builtin_amdgcn_readfirstlane(tid >> 6), lane = tid & 63, wr = wid >> 2, wc = wid & 3, fr = lane & 15, fq = lane >> 4;
    const int K = g.K, nt = K / BK;
    unsigned voffB[2]; int Ra[2], Ca[2];
#pragma unroll
    for (int i = 0; i < 2; ++i) { int R, C; stage_rc(tid * 16 + i * 8192, R, C); const int Rb = (R & ~31) + perm32(R & 31);
        Ra[i] = R; Ca[i] = C; voffB[i] = (unsigned)(Rb * K + C) * 2u; }
    unsigned goA[2][2], gnA[2][2];
#define PG8_ROWS(dst, unit) do { _Pragma("unroll") for (int _h = 0; _h < 2; ++_h) _Pragma("unroll") for (int _i = 0; _i < 2; ++_i) \
        dst[_h][_i] = (S.rowid(unit, _h, Ra[_i]) * (unsigned)K + (unsigned)Ca[_i]) * 2u; } while (0)
#define PG8_STAGEA(bufoff, kb, offs) do { _Pragma("unroll") for (int _i = 0; _i < 2; ++_i) \
        __builtin_amdgcn_global_load_lds((const unsigned*)(gA + (kb) + (offs)[_i]), (LAS unsigned*)(lds + (bufoff) + ldsw + _i * 8192), 16, 0, 0); } while (0)
    const size_t kstep = (size_t)(BK * 2);
    const size_t hstep = (size_t)HALF * K * 2;
    const size_t tstep = 2 * hstep;
    const unsigned ldsw = (unsigned)wid * 1024u;
    const int aoff = lds_byte(wr * 64 + fr, fq * 8), boff = lds_byte(wc * 32 + fr, fq * 8);
#define PG8_SA(b, h) (((b) * 2 + (h)) * HTB)
#define PG8_SB(b, h) ((4 + (b) * 2 + (h)) * HTB)
#define PG8_STAGE(bufoff, gbase, voff) do { _Pragma("unroll") for (int _i = 0; _i < 2; ++_i) \
        __builtin_amdgcn_global_load_lds((const unsigned*)((const char*)(gbase) + (voff)[_i]), (LAS unsigned*)(lds + (bufoff) + ldsw + _i * 8192), 16, 0, 0); } while (0)
#define PG8_LDA(dst, b, h) do { _Pragma("unroll") for (int m = 0; m < 4; ++m) _Pragma("unroll") for (int k = 0; k < 2; ++k) dst[m][k] = *(const LAS bf16x8*)(lds + PG8_SA(b, h) + aoff + m * 2048 + k * 1024); } while (0)
#define PG8_LDB(dst, b, h) do { _Pragma("unroll") for (int n = 0; n < 2; ++n) _Pragma("unroll") for (int k = 0; k < 2; ++k) dst[n][k] = *(const LAS bf16x8*)(lds + PG8_SB(b, h) + boff + n * 2048 + k * 1024); } while (0)
#define PG8_MMA(ai, bj, At, Bt) do { __builtin_amdgcn_s_setprio(1); _Pragma("unroll") for (int m = 0; m < 4; ++m) _Pragma("unroll") for (int n = 0; n < 2; ++n) _Pragma("unroll") for (int k = 0; k < 2; ++k) \
        acc[ai][bj][m][n] = __builtin_amdgcn_mfma_f32_16x16x32_bf16(Bt[n][k], At[m][k], acc[ai][bj][m][n], 0, 0, 0); __builtin_amdgcn_s_setprio(0); } while (0)
#define PG8_WAIT_V(n) asm volatile("s_waitcnt vmcnt(" #n ")" ::: "memory")
#define PG8_WAIT_L(n) asm volatile("s_waitcnt lgkmcnt(" #n ")" ::: "memory")
#define PG8_BAR __builtin_amdgcn_s_barrier()
#define PG8_SCHED __builtin_amdgcn_sched_barrier(0)
    Unit cur, nxt; int ui = 0;
    if (!S.next(0, cur)) return;
    f32x4 acc[2][2][4][2];
#pragma unroll
    for (int a = 0; a < 2; ++a)
#pragma unroll
        for (int b = 0; b < 2; ++b)
#pragma unroll
            for (int m = 0; m < 4; ++m)
#pragma unroll
                for (int n = 0; n < 2; ++n) acc[a][b][m][n] = (f32x4){0.f, 0.f, 0.f, 0.f};
    bf16x8 At[4][2], B0[2][2], B1[2][2];
    const char* const gA = (const char*)g.A; const char* cB = (const char*)g.Bt + (size_t)cur.pn * tstep;
    PG8_ROWS(goA, cur);
    {
        PG8_STAGE(PG8_SB(0, 0), cB, voffB); PG8_STAGE(PG8_SB(0, 1), cB + hstep, voffB); PG8_STAGEA(PG8_SA(0, 0), 0, goA[0]); PG8_STAGEA(PG8_SA(0, 1), 0, goA[1]);
        if (wr == 1) PG8_BAR;
        PG8_WAIT_V(2); PG8_BAR;
        PG8_STAGE(PG8_SB(1, 0), cB + kstep, voffB); PG8_STAGEA(PG8_SA(1, 0), kstep, goA[0]); PG8_STAGE(PG8_SB(1, 1), cB + hstep + kstep, voffB);
        PG8_WAIT_V(6); PG8_BAR;
    }
    for (;;) {
        const bool has_next = S.next(ui + 1, nxt);
        const char* nB = has_next ? (const char*)g.Bt + (size_t)nxt.pn * tstep : cB;
        if (has_next) PG8_ROWS(gnA, nxt); else { gnA[0][0] = goA[0][0]; gnA[0][1] = goA[0][1]; gnA[1][0] = goA[1][0]; gnA[1][1] = goA[1][1]; }
        for (int t = 0; t < nt; t += 2) {
            const bool last = (t == nt - 2);
            const unsigned k1 = (unsigned)(t + 1) * (unsigned)kstep;
            const unsigned k2 = last ? 0u : (unsigned)(t + 2) * (unsigned)kstep, k3 = k2 + (unsigned)kstep;
            unsigned o2[2][2];
#pragma unroll
            for (int _h = 0; _h < 2; ++_h)
#pragma unroll
                for (int _i = 0; _i < 2; ++_i) o2[_h][_i] = last ? gnA[_h][_i] : goA[_h][_i];
            const char* b2 = last ? nB : cB + (size_t)(t + 2) * kstep;
            const char* b3 = b2 + kstep;
            if constexpr (SP2) {
            PG8_LDB(B0, 0, 0); PG8_LDB(B1, 0, 1); PG8_SCHED; PG8_LDA(At, 0, 0); PG8_STAGEA(PG8_SA(1, 1), k1, goA[1]);
            PG8_WAIT_V(8); PG8_WAIT_L(0); PG8_BAR; PG8_MMA(0, 0, At, B0); PG8_MMA(0, 1, At, B1); PG8_BAR; PG8_SCHED;
            PG8_LDA(At, 0, 1); PG8_STAGE(PG8_SB(0, 0), b2, voffB); PG8_STAGE(PG8_SB(0, 1), b2 + hstep, voffB); PG8_STAGEA(PG8_SA(0, 0), k2, o2[0]);
            PG8_WAIT_V(8); PG8_WAIT_L(0); PG8_BAR; PG8_MMA(1, 0, At, B0); PG8_MMA(1, 1, At, B1); PG8_BAR; PG8_SCHED;
            PG8_LDB(B0, 1, 0); PG8_LDB(B1, 1, 1); PG8_SCHED; PG8_LDA(At, 1, 0); PG8_STAGEA(PG8_SA(0, 1), k2, o2[1]);
            PG8_WAIT_V(8); PG8_WAIT_L(0); PG8_BAR; PG8_MMA(0, 0, At, B0); PG8_MMA(0, 1, At, B1); PG8_BAR; PG8_SCHED;
            PG8_LDA(At, 1, 1); PG8_STAGE(PG8_SB(1, 0), b3, voffB); PG8_STAGE(PG8_SB(1, 1), b3 + hstep, voffB); PG8_STAGEA(PG8_SA(1, 0), k3, o2[0]);
            PG8_WAIT_V(8); PG8_WAIT_L(0); PG8_BAR; PG8_MMA(1, 0, At, B0); PG8_MMA(1, 1, At, B1); PG8_BAR; PG8_SCHED;
            } else {
            static_assert(SP2, "only the SP2 loop is kept");
            }
        }
        if constexpr (ALIGN_EPI) { if (wr == 0) PG8_BAR; }
        E(acc, cur, wr, wc, fr, fq);
        if (!has_next) break;
#pragma unroll
        for (int a = 0; a < 2; ++a)
#pragma unroll
            for (int b = 0; b < 2; ++b)
#pragma unroll
                for (int m = 0; m < 4; ++m)
#pragma unroll
                    for (int n = 0; n < 2; ++n) acc[a][b][m][n] = (f32x4){0.f, 0.f, 0.f, 0.f};
        cur = nxt; cB = nB; ++ui;
        goA[0][0] = gnA[0][0]; goA[0][1] = gnA[0][1]; goA[1][0] = gnA[1][0]; goA[1][1] = gnA[1][1];
        if constexpr (ALIGN_EPI) { if (wr == 1) PG8_BAR; }
    }
    PG8_WAIT_V(0);
    if constexpr (!ALIGN_EPI) { if (wr == 0) PG8_BAR; }
    PG8_BAR;
#undef PG8_SA
#undef PG8_SB
#undef PG8_STAGE
#undef PG8_STAGEA
#undef PG8_ROWS
#undef PG8_LDA
#undef PG8_LDB
#undef PG8_MMA
#undef PG8_WAIT_V
#undef PG8_WAIT_L
#undef PG8_BAR
#undef PG8_SCHED
}
}

constexpr int DM = 2048, NB = 4, SEQ = 4096, CL = 256, RPB = SEQ + CL, MROWS = NB * RPB, MT = MROWS / 256;
constexpr int NE = 64, FF = 512, A_IN = 4608, LCAP = 17408;
constexpr int XS_BLK = 472, SH_BLK = 68;
constexpr float DN_ALPHA = 1.4142135623730951f;
constexpr float LN_EPS = 1e-5f, RMS_EPS = 1e-6f;

constexpr size_t MiB = 1u << 20;
constexpr size_t WS_CTL = 0, CTL_ZERO_BYTES = 1 * MiB;
constexpr size_t WS_MOD = 1 * MiB;
constexpr size_t WS_ROPE128 = 2 * MiB;
constexpr size_t WS_ROPE64 = 4 * MiB;
constexpr size_t WS_TE = 5 * MiB;
constexpr size_t WS_TW = 6 * MiB;
constexpr size_t WS_INV = 7 * MiB;
constexpr size_t WS_W_IN = 8 * MiB;
constexpr size_t WS_W_OUT0 = 26 * MiB;
constexpr size_t WS_W_DOWN = 34 * MiB;
constexpr size_t WS_W_UQKV = 39 * MiB;
constexpr size_t WS_W_OUT1 = 46 * MiB;
constexpr size_t WS_W_RT = 54 * MiB;
constexpr size_t WS_W_GU = 56 * MiB;
constexpr size_t WS_W_D = 576 * MiB;
constexpr size_t WS_X = 836 * MiB;
constexpr size_t WS_UM = 972 * MiB;
constexpr size_t WS_XS = 1040 * MiB;
constexpr size_t WS_U = WS_XS + (size_t)XS_BLK * MiB;
constexpr size_t WS_ULO = WS_U + (size_t)SH_BLK * MiB;
constexpr size_t WS_Y = WS_XS;
constexpr size_t WS_H = 1648 * MiB;
constexpr size_t WS_PROJ = 1783 * MiB;
constexpr size_t WS_Y1_0 = WS_PROJ;
constexpr size_t WS_MIX = 1936 * MiB;
constexpr size_t WS_LOG = 2004 * MiB;
constexpr size_t WS_LIST = 2022 * MiB;
constexpr size_t WS_END = 2027 * MiB;
constexpr size_t WS_DOWNP = 1040 * MiB;
constexpr size_t WS_CQKV = 1083 * MiB;
constexpr size_t WS_KR = 1117 * MiB;
constexpr size_t WS_QB = 1120 * MiB;
constexpr size_t WS_KVB = 1222 * MiB;
constexpr size_t WS_ATT = 1358 * MiB;
constexpr size_t WS_Y1_1 = 1426 * MiB;
static_assert(WS_Y1_1 + 68 * MiB <= WS_U, "layer-1 mixer buffers inside XS");
constexpr size_t W_GU_L = (size_t)65 * 1024 * 2048, W_D_L = (size_t)65 * 2048 * 512;

constexpr int CW_TMO = 0, CW_BAR = 4096, CW_CNT = 8192, CW_NBLK = 8192 + 256;

constexpr int LDS_BYTES = 155648, RING_BYTES = 147456, MISC_OFF = RING_BYTES + 320;
constexpr int MOE_TAB_OFF = 131072;

#define XB_TMO      128
#define XB_XCNT(j)  (256  + 64 * (j))
#define XB_XSUB(j)  (1280 + 64 * (j))
#define XB_XGEN(j)  (2304 + 64 * (j))
#define XB_TOP      3328
#define XB_TOPGEN   3392
#define XCD_BAR_WORDS 3456
#define XB_SPIN_CAP (1u << 18)
__device__ __forceinline__ unsigned xb_ld(unsigned* p)              { return __hip_atomic_load(p, __ATOMIC_RELAXED, __HIP_MEMORY_SCOPE_AGENT); }
__device__ __forceinline__ unsigned xb_add(unsigned* p, unsigned v) { return __hip_atomic_fetch_add(p, v, __ATOMIC_RELAXED, __HIP_MEMORY_SCOPE_AGENT); }
__device__ __forceinline__ unsigned xb_xcc_id() { return (unsigned)__builtin_amdgcn_s_getreg((3 << 11) | 20) & 0xFu; }
#define XB_SPIN(cond, bar) do { unsigned _sp = 0; while (cond) { __builtin_amdgcn_s_sleep(1); \
    if ((++_sp & 255u) == 0u) { if (xb_ld(&(bar)[XB_TMO])) break; if (_sp > XB_SPIN_CAP) { atomicAdd(&(bar)[XB_TMO], 1u); break; } } } } while (0)
struct XcdBarrier { unsigned* bar; unsigned x; volatile LAS unsigned* st; };
__device__ __forceinline__ XcdBarrier xcd_barrier_post(unsigned* bar, volatile LAS unsigned* st) {
    XcdBarrier b; b.bar = bar; b.x = xb_xcc_id(); b.st = st;
    if (threadIdx.x == 0) (void)xb_add(&bar[XB_XCNT(b.x)], 1u);
    return b;
}
__device__ __forceinline__ void xcd_barrier_complete(unsigned* bar, unsigned x, unsigned& nloc, unsigned& nx) {
    const unsigned G = gridDim.x * gridDim.y * gridDim.z;
    unsigned sum, cnt, mine, sp = 0u;
    for (;;) {
        sum = 0u; cnt = 0u; mine = 0u;
#pragma unroll
        for (unsigned j = 0; j < 16; ++j) { const unsigned c = xb_ld(&bar[XB_XCNT(j)]); sum += c; cnt += (c > 0u) ? 1u : 0u; mine = (j == x) ? c : mine; }
        if (sum == G) break;
        __builtin_amdgcn_s_sleep(1);
        if ((++sp & 255u) == 0u) { if (xb_ld(&bar[XB_TMO])) break; if (sp > XB_SPIN_CAP) { atomicAdd(&bar[XB_TMO], 1u); break; } }
    }
    nloc = mine > 0u ? mine : 1u; nx = cnt > 0u ? cnt : 1u;
}
__device__ __forceinline__ void xcd_barrier(const XcdBarrier& b) {
    asm volatile("s_waitcnt vmcnt(0)" ::: "memory");
    __syncthreads();
    if (threadIdx.x == 0) {
        unsigned* bar = b.bar;
        __builtin_amdgcn_s_waitcnt(0);
        unsigned nloc = b.st[0], nx = b.st[1];
        if (nloc == 0u) { xcd_barrier_complete(bar, b.x, nloc, nx); b.st[0] = nloc; b.st[1] = nx; }
        const unsigned old = xb_add(&bar[XB_XSUB(b.x)], 1u);
        const unsigned gen = old / nloc;
        if (old + 1u == (gen + 1u) * nloc) {
            __builtin_amdgcn_fence(__ATOMIC_RELEASE, "agent");
            asm volatile("s_waitcnt vmcnt(0)" ::: "memory");
            const unsigned og = xb_add(&bar[XB_TOP], 1u);
            const unsigned tg = og / nx;
            if (og + 1u == (tg + 1u) * nx) xb_add(&bar[XB_TOPGEN], 1u);
            else XB_SPIN(xb_ld(&bar[XB_TOPGEN]) == tg, bar);
            __builtin_amdgcn_fence(__ATOMIC_ACQUIRE, "agent");
            xb_add(&bar[XB_XGEN(b.x)], 1u);
            asm volatile("s_waitcnt vmcnt(0)" ::: "memory");
        } else {
            XB_SPIN(xb_ld(&bar[XB_XGEN(b.x)]) == gen, bar);
            __builtin_amdgcn_fence(__ATOMIC_ACQUIRE, "agent");
            asm volatile("s_waitcnt vmcnt(0)" ::: "memory");
        }
    }
    __syncthreads();
}

struct Args { const float* in[27]; float* out; unsigned char* ws; int ph_lo, ph_hi; };
enum { I_X = 0, I_C, I_CTX, I_CCTX, I_WADA, I_BADA, I_LNG, I_LNB, I_AWIN, I_ACONV, I_AQG, I_AKG, I_AWOUT, I_MWDOWN, I_MQG, I_MKVG, I_MWUQ, I_MWUKV, I_MWOUT,
       I_RW, I_RB, I_EWG, I_EWU, I_EWD, I_SWG, I_SWU, I_SWD };

struct Ctx {
    LAS unsigned char* lds; int tid, lane, wave, G, bid, vcu, gw, ngw;
    unsigned char* ws; unsigned* ctl;
};
__device__ __forceinline__ void row_info(int r, int& b, int& p) { b = r / RPB; p = r - b * RPB; }
__device__ __forceinline__ const float* in_row(const Args& a, int b, int p) {
    return p < CL ? a.in[I_CTX] + ((size_t)(b * CL + p)) * DM : a.in[I_X] + ((size_t)(b * SEQ + (p - CL))) * DM;
}

template <bool SPLIT>
__device__ __forceinline__ void tr_item(const float* __restrict__ src, int ldw, bf16* dst, bf16* dst_lo, int ldd, LAS float* scr, int lane) {
#pragma unroll 8
    for (int i = 0; i < 32; ++i) { const int kk = 2 * i + (lane >> 5); scr[kk * 33 + (lane & 31)] = src[(size_t)kk * ldw + (lane & 31)]; }
    LDS_WAIT(); asm volatile("" ::: "memory");
    const int c = lane & 7;
#pragma unroll
    for (int j = 0; j < 4; ++j) { const int n = (lane >> 3) + 8 * j; const LAS float* s = scr + (8 * c) * 33 + n;
        float v[8];
#pragma unroll
        for (int q = 0; q < 8; ++q) v[q] = s[q * 33];
        u32x4 o; o.x = cvt_pk_bf16(v[0], v[1]); o.y = cvt_pk_bf16(v[2], v[3]); o.z = cvt_pk_bf16(v[4], v[5]); o.w = cvt_pk_bf16(v[6], v[7]);
        *(u32x4*)(dst + (size_t)n * ldd + 8 * c) = o;
        if constexpr (SPLIT) {
            u32x4 l; l.x = cvt_pk_bf16(v[0] - bf_lo(o.x), v[1] - bf_hi(o.x)); l.y = cvt_pk_bf16(v[2] - bf_lo(o.y), v[3] - bf_hi(o.y));
            l.z = cvt_pk_bf16(v[4] - bf_lo(o.z), v[5] - bf_hi(o.z)); l.w = cvt_pk_bf16(v[6] - bf_lo(o.w), v[7] - bf_hi(o.w));
            *(u32x4*)(dst_lo + (size_t)n * ldd + 8 * c) = l;
        }
    }
    LDS_WAIT(); asm volatile("" ::: "memory");
}

__device__ __forceinline__ void p0_prologue(const Ctx& C, const Args& a) {
    unsigned char* ws = C.ws;
    {
        LAS float* sv = (LAS float*)C.lds;
        LAS float* red = (LAS float*)(C.lds + 40960);
        for (int i = C.tid; i < 5 * DM; i += 512) { const int r = i / DM, k = i - r * DM; const float c = (r < 4) ? a.in[I_C][r * DM + k] : a.in[I_CCTX][k]; sv[i] = c / (1.f + __expf(-c)); }
        __syncthreads();
        float* mod = (float*)(ws + WS_MOD);
        for (int chunk = C.bid; chunk < 256; chunk += C.G) {
            const int l = chunk >> 7, col0 = (chunk & 127) * 96;
            if (C.tid < 384) {
                const int cg = C.tid % 24, ks = C.tid / 24;
                f32x4 acc[5];
#pragma unroll
                for (int r = 0; r < 5; ++r) acc[r] = (f32x4){0.f, 0.f, 0.f, 0.f};
                const float* W = a.in[I_WADA] + ((size_t)l * DM + ks * 128) * 12288 + col0 + 4 * cg;
                const LAS float* s0 = sv + ks * 128;
#pragma unroll 8
                for (int k = 0; k < 128; ++k) { const f32x4 w = *(const f32x4*)(W + (size_t)k * 12288);
#pragma unroll
                    for (int r = 0; r < 5; ++r) { const float s = s0[r * DM + k]; acc[r] += w * s; } }
#pragma unroll
                for (int r = 0; r < 5; ++r) *(LAS f32x4*)(red + (ks * 5 + r) * 96 + 4 * cg) = acc[r];
            }
            __syncthreads();
            if (C.tid < 480) { const int r = C.tid / 96, c = C.tid - r * 96; float s = a.in[I_BADA][l * 12288 + col0 + c];
#pragma unroll
                for (int ks = 0; ks < 16; ++ks) s += red[(ks * 5 + r) * 96 + c];
                mod[((size_t)l * 5 + r) * 12288 + col0 + c] = s; }
            __syncthreads();
        }
    }
    {
        f32x2* r128 = (f32x2*)(ws + WS_ROPE128); f32x2* r64 = (f32x2*)(ws + WS_ROPE64);
        const int gt = C.bid * 512 + C.tid, ngt = C.G * 512;
        for (int i = gt; i < SEQ * 64; i += ngt) { const int s = i >> 6, j = i & 63; const float pos = (float)((j < 32) ? (s >> 6) : (s & 63)); const int f = j & 31;
            const float inv = exp2f(-(float)f * (13.287712379549449f / 32.f)); const float ang = pos * inv; r128[i] = (f32x2){cosf(ang), sinf(ang)}; }
        for (int i = gt; i < SEQ * 32; i += ngt) { const int s = i >> 5, j = i & 31; const float pos = (float)((j < 16) ? (s >> 6) : (s & 63)); const int f = j & 15;
            const float inv = exp2f(-(float)f * (13.287712379549449f / 16.f)); const float ang = pos * inv; r64[i] = (f32x2){cosf(ang), sinf(ang)}; }
        const u32x4 z = {0u, 0u, 0u, 0u};
        u32x4* zd = (u32x4*)(ws + WS_W_DOWN + (size_t)1088 * 4096);
        for (int i = gt; i < 192 * 256; i += ngt) zd[i] = z;
        for (int l = 0; l < 2; ++l) { u32x4* zr = (u32x4*)(ws + WS_W_RT + (size_t)l * 256 * 4096 + (size_t)128 * 4096); for (int i = gt; i < 128 * 256; i += ngt) zr[i] = z; }
    }
    __syncthreads();
    {
        LAS float* scr = (LAS float*)(C.lds + C.wave * 16384);
        constexpr int J0 = 32 * 144, J1 = 32 * 64, J2 = 32 * 34, J3 = 8 * 96, J4 = 8 * 128, J5 = 32 * 64, J6 = 2 * 32 * 2, J7 = 2 * 64 * 512, J8 = J7, J9 = 2 * 64 * 512, J10 = 2 * 512, J11 = J10, J12 = 2 * 512;
        constexpr int NITEMS = J0 + J1 + J2 + J3 + J4 + J5 + J6 + J7 + J8 + J9 + J10 + J11 + J12;
        bf16* w_in = (bf16*)(ws + WS_W_IN); bf16* w_out0 = (bf16*)(ws + WS_W_OUT0); bf16* w_down = (bf16*)(ws + WS_W_DOWN); bf16* w_uqkv = (bf16*)(ws + WS_W_UQKV);
        bf16* w_out1 = (bf16*)(ws + WS_W_OUT1); bf16* w_rt = (bf16*)(ws + WS_W_RT); bf16* w_gu = (bf16*)(ws + WS_W_GU); bf16* w_d = (bf16*)(ws + WS_W_D);
        for (int it = C.gw; it < NITEMS; it += C.ngw) {
            int r = it;
            if (r < J0) { const int kb = r / 144, nb = r % 144; tr_item<false>(a.in[I_AWIN] + (size_t)kb * 64 * A_IN + nb * 32, A_IN, w_in + (size_t)nb * 32 * DM + kb * 64, nullptr, DM, scr, C.lane); continue; } r -= J0;
            if (r < J1) { const int kb = r / 64, nb = r % 64; tr_item<false>(a.in[I_AWOUT] + (size_t)kb * 64 * DM + nb * 32, DM, w_out0 + (size_t)nb * 32 * DM + kb * 64, nullptr, DM, scr, C.lane); continue; } r -= J1;
            if (r < J2) { const int kb = r / 34, nb = r % 34; tr_item<false>(a.in[I_MWDOWN] + (size_t)kb * 64 * 1088 + nb * 32, 1088, w_down + (size_t)nb * 32 * DM + kb * 64, nullptr, DM, scr, C.lane); continue; } r -= J2;
            if (r < J3) { const int kb = r / 96, nb = r % 96; const int n0 = nb * 32, h = n0 / 192, d = n0 - h * 192;
                const int row = (d < 128) ? (128 * h + d) : (2048 + 256 * (h >> 2) + ((d - 128) ? 128 : 0) + 32 * (h & 3));
                tr_item<false>(a.in[I_MWUQ] + (size_t)kb * 64 * 3072 + n0, 3072, w_uqkv + (size_t)row * 512 + kb * 64, nullptr, 512, scr, C.lane); continue; } r -= J3;
            if (r < J4) { const int kb = r / 128, nb = r % 128; tr_item<false>(a.in[I_MWUKV] + (size_t)kb * 64 * 4096 + nb * 32, 4096, w_uqkv + (size_t)(3072 + nb * 32) * 512 + kb * 64, nullptr, 512, scr, C.lane); continue; } r -= J4;
            if (r < J5) { const int kb = r / 64, nb = r % 64; tr_item<false>(a.in[I_MWOUT] + (size_t)kb * 64 * DM + nb * 32, DM, w_out1 + (size_t)nb * 32 * DM + kb * 64, nullptr, DM, scr, C.lane); continue; } r -= J5;
            if (r < J6) { const int l = r / 64, q = r % 64, kb = q / 2, nb = q % 2; bf16* d = w_rt + (size_t)l * 256 * DM + (size_t)nb * 32 * DM + kb * 64;
                tr_item<true>(a.in[I_RW] + ((size_t)l * DM + kb * 64) * 64 + nb * 32, 64, d, d + (size_t)64 * DM, DM, scr, C.lane); continue; } r -= J6;
            if (r < J7 + J8) { const int up = r >= J7; if (up) r -= J7; const int le = r / 512, q = r % 512, kb = q / 16, nb = q % 16, n0 = nb * 32, l = le >> 6, e = le & 63;
                const float* src = (up ? a.in[I_EWU] : a.in[I_EWG]) + ((size_t)le * DM + kb * 64) * FF + n0;
                bf16* d = w_gu + (size_t)l * W_GU_L + ((size_t)e * 1024 + 256 * (n0 >> 7) + (up ? 128 : 0) + (n0 & 127)) * DM + kb * 64;
                tr_item<false>(src, FF, d, nullptr, DM, scr, C.lane); continue; } r -= J7 + J8;
            if (r < J9) { const int le = r / 512, q = r % 512, kb = q / 64, nb = q % 64, l = le >> 6, e = le & 63;
                tr_item<false>(a.in[I_EWD] + ((size_t)le * FF + kb * 64) * DM + nb * 32, DM, w_d + (size_t)l * W_D_L + ((size_t)e * 2048 + nb * 32) * FF + kb * 64, nullptr, FF, scr, C.lane); continue; } r -= J9;
            if (r < J10 + J11) { const int up = r >= J10; if (up) r -= J10; const int l = r / 512, q = r % 512, kb = q / 16, nb = q % 16, n0 = nb * 32;
                const float* src = (up ? a.in[I_SWU] : a.in[I_SWG]) + ((size_t)l * DM + kb * 64) * FF + n0;
                bf16* d = w_gu + (size_t)l * W_GU_L + ((size_t)NE * 1024 + 256 * (n0 >> 7) + (up ? 128 : 0) + (n0 & 127)) * DM + kb * 64;
                tr_item<false>(src, FF, d, nullptr, DM, scr, C.lane); continue; } r -= J10 + J11;
            { const int l = r / 512, q = r % 512, kb = q / 64, nb = q % 64;
                tr_item<false>(a.in[I_SWD] + ((size_t)l * FF + kb * 64) * DM + nb * 32, DM, w_d + (size_t)l * W_D_L + ((size_t)NE * 2048 + nb * 32) * FF + kb * 64, nullptr, FF, scr, C.lane); }
        }
    }
}

__device__ __forceinline__ void p1_modulate0(const Ctx& C, const Args& a) {
    const float* mod = (const float*)(C.ws + WS_MOD); bf16* um = (bf16*)(C.ws + WS_UM);
    for (int r = C.gw; r < MROWS; r += C.ngw) {
        int b, p; row_info(r, b, p); const float* xr = in_row(a, b, p); const float* mr = mod + (size_t)(p < CL ? 4 : b) * 12288;
#pragma unroll
        for (int j = 0; j < 8; ++j) { const int e = 4 * (C.lane + 64 * j); const f32x4 x = *(const f32x4*)(xr + e), sh = *(const f32x4*)(mr + e), sc = *(const f32x4*)(mr + 2048 + e);
            const f32x4 u = x * (sc + 1.f) + sh; u32x2 w; w.x = cvt_pk_bf16(u[0], u[1]); w.y = cvt_pk_bf16(u[2], u[3]); *(u32x2*)(um + (size_t)r * DM + e) = w; }
    }
}

struct EpiStoreBf16 {
    bf16* O; int ldc;
    __device__ __forceinline__ void operator()(const f32x4 (&acc)[2][2][4][2], const pg8::Unit& u, int wr, int wc, int fr, int fq) const {
        const int row0 = u.pm * 256 + wr * 64 + fr, col0 = u.pn * 256 + wc * 32 + 8 * fq;
#pragma unroll
        for (int ai = 0; ai < 2; ++ai)
#pragma unroll
            for (int m = 0; m < 4; ++m) { bf16* rowp = O + (size_t)(row0 + ai * 128 + m * 16) * ldc + col0;
#pragma unroll
                for (int bj = 0; bj < 2; ++bj) { const f32x4 v0 = acc[ai][bj][m][0], v1 = acc[ai][bj][m][1];
                    u32x4 w; w.x = cvt_pk_bf16(v0[0], v0[1]); w.y = cvt_pk_bf16(v0[2], v0[3]); w.z = cvt_pk_bf16(v1[0], v1[1]); w.w = cvt_pk_bf16(v1[2], v1[3]);
                    *(u32x4*)(rowp + bj * 128) = w; } }
    }
};
struct DenseSched {
    int nM, nN, G, c, lat_only, pm_off, pn_off;
    __device__ __forceinline__ bool next(int i, pg8::Unit& u) const {
        const long L = (long)i * G + c; const int nwg = nM * nN; if (L >= nwg) return false;
        const int w = pg8::xcd_remap((int)L, nwg); int pm, pn; pg8::tile_of(w, nM, nN, pm, pn);
        if (lat_only) pm = 17 * (pm >> 4) + 1 + (pm & 15);
        u.pm = pm + pm_off; u.pn = pn + pn_off; return true;
    }
    __device__ __forceinline__ unsigned rowid(const pg8::Unit& u, int h, int R) const { return (unsigned)(u.pm * 256 + h * 128 + R); }
};

__device__ __forceinline__ void p3_qk_conv(const Ctx& C, const Args& a) {
    bf16* proj = (bf16*)(C.ws + WS_PROJ); bf16* mix = (bf16*)(C.ws + WS_MIX);
    const f32x2* rope = (const f32x2*)(C.ws + WS_ROPE128);
    const float qg0 = a.in[I_AQG][C.lane], qg1 = a.in[I_AQG][C.lane + 64], kg0 = a.in[I_AKG][C.lane], kg1 = a.in[I_AKG][C.lane + 64];
    const float* cw = a.in[I_ACONV];
    for (int r = C.gw; r < MROWS; r += C.ngw) {
        int b, p; row_info(r, b, p); const bool isctx = p < CL;
        bf16* pr = proj + (size_t)r * A_IN;
        f32x2 cs = {1.f, 0.f}; if (!isctx) cs = rope[(size_t)(p - CL) * 64 + C.lane];
#pragma unroll
        for (int h = 0; h < 10; ++h) {
            bf16* hp = pr + 3072 + 128 * h;
            const float x1 = bf2f(hp[C.lane]), x2 = bf2f(hp[C.lane + 64]);
            const float ss = wave_sum(x1 * x1 + x2 * x2);
            const float rs = 1.f / sqrtf(ss * (1.f / 128.f) + RMS_EPS);
            const float y1 = x1 * rs * (h < 8 ? qg0 : kg0), y2 = x2 * rs * (h < 8 ? qg1 : kg1);
            hp[C.lane] = (bf16)f2bf(y1 * cs.x - y2 * cs.y); hp[C.lane + 64] = (bf16)f2bf(y2 * cs.x + y1 * cs.y);
        }
        const int pos = isctx ? p : p - CL, len = isctx ? CL : SEQ;
        const bool hasm = pos > 0, hasp = pos + 1 < len;
#pragma unroll
        for (int j = 0; j < 2; ++j) {
            const int c0 = 8 * (C.lane + 64 * j);
            const u32x4 gb = *(const u32x4*)(pr + c0), gc = *(const u32x4*)(pr + 1024 + c0), hv = *(const u32x4*)(pr + 2048 + c0);
            u32x4 gcm = {0u, 0u, 0u, 0u}, hvm = gcm, gcp = gcm, hvp = gcm;
            if (hasm) { gcm = *(const u32x4*)(pr - A_IN + 1024 + c0); hvm = *(const u32x4*)(pr - A_IN + 2048 + c0); }
            if (hasp) { gcp = *(const u32x4*)(pr + A_IN + 1024 + c0); hvp = *(const u32x4*)(pr + A_IN + 2048 + c0); }
            const f32x4 w0a = *(const f32x4*)(cw + c0), w0b = *(const f32x4*)(cw + c0 + 4), w1a = *(const f32x4*)(cw + 1024 + c0), w1b = *(const f32x4*)(cw + 1024 + c0 + 4),
                        w2a = *(const f32x4*)(cw + 2048 + c0), w2b = *(const f32x4*)(cw + 2048 + c0 + 4);
            float o[8];
#pragma unroll
            for (int q = 0; q < 4; ++q) {
                const float w0l = q < 2 ? w0a[2 * q] : w0b[2 * q - 4], w0h = q < 2 ? w0a[2 * q + 1] : w0b[2 * q - 3];
                const float w1l = q < 2 ? w1a[2 * q] : w1b[2 * q - 4], w1h = q < 2 ? w1a[2 * q + 1] : w1b[2 * q - 3];
                const float w2l = q < 2 ? w2a[2 * q] : w2b[2 * q - 4], w2h = q < 2 ? w2a[2 * q + 1] : w2b[2 * q - 3];
                const float zl = bf_lo(gc[q]) * bf_lo(hv[q]), zh = bf_hi(gc[q]) * bf_hi(hv[q]);
                const float zml = bf_lo(gcm[q]) * bf_lo(hvm[q]), zmh = bf_hi(gcm[q]) * bf_hi(hvm[q]);
                const float zpl = bf_lo(gcp[q]) * bf_lo(hvp[q]), zph = bf_hi(gcp[q]) * bf_hi(hvp[q]);
                o[2 * q] = bf_lo(gb[q]) * (w0l * zml + w1l * zl + w2l * zpl);
                o[2 * q + 1] = bf_hi(gb[q]) * (w0h * zmh + w1h * zh + w2h * zph);
            }
            u32x4 w; w.x = cvt_pk_bf16(o[0], o[1]); w.y = cvt_pk_bf16(o[2], o[3]); w.z = cvt_pk_bf16(o[4], o[5]); w.w = cvt_pk_bf16(o[6], o[7]);
            *(u32x4*)(mix + (size_t)r * DM + c0) = w;
        }
    }
}

namespace att {
constexpr int NW = 8, QBLK = 32, KVBLK = 64;
constexpr int SHM_V = KVBLK * 128 * 2, SHM_K = KVBLK * 128 * 2, SHM_KR = KVBLK * 64 * 2;
constexpr int OFF_V = 0, OFF_K = 2 * SHM_V, OFF_KR = 2 * SHM_V + 2 * SHM_K, OFF_QR = OFF_KR + 2 * SHM_KR, LDS_ATT = OFF_QR + NW * 8192;
constexpr float THR = 8.f;
#define KSWZ(row, colB) ((row) * 256 + ((colB) ^ (((row) & 7) << 4)))
#define KRSWZ(row, colB) ((row) * 128 + ((colB) ^ (((row) & 7) << 4)))
__device__ __forceinline__ bf16x8 ld8(const bf16* p) { return *reinterpret_cast<const bf16x8*>(p); }

__device__ __forceinline__ void partialSM(f32x16& p0, f32x16& p1, float& m_reg, float& mn, float& alpha, const float SCALE) {
    const float Cc = SCALE * 1.4426950408889634f;
    float pmax = p0[0];
#pragma unroll
    for (int r = 1; r < 16; ++r) pmax = fmaxf(pmax, p0[r]);
#pragma unroll
    for (int r = 0; r < 16; ++r) pmax = fmaxf(pmax, p1[r]);
    { auto rr = __builtin_amdgcn_permlane32_swap(__float_as_uint(pmax), __float_as_uint(pmax), false, false);
      pmax = fmaxf(__uint_as_float(rr[0]), __uint_as_float(rr[1])); }
    if (__builtin_expect(__all(pmax - m_reg <= THR / SCALE), 1)) { mn = m_reg; alpha = 1.f; }
    else { mn = fmaxf(m_reg, pmax); alpha = __builtin_amdgcn_exp2f((m_reg - mn) * Cc); m_reg = mn; }
    const float mnC = -mn * Cc;
#pragma unroll
    for (int r = 0; r < 16; ++r) p0[r] = fmaf(p0[r], Cc, mnC);
#pragma unroll
    for (int r = 0; r < 16; ++r) p1[r] = fmaf(p1[r], Cc, mnC);
#pragma unroll
    for (int r = 0; r < 16; ++r) p0[r] = __builtin_amdgcn_exp2f(p0[r]);
}
__device__ __forceinline__ void finishSM(f32x16& p0, f32x16& p1, float alpha, float& l_reg, bf16x8& pa0, bf16x8& pa1, bf16x8& pa2, bf16x8& pa3) {
#pragma unroll
    for (int r = 0; r < 16; ++r) p1[r] = __builtin_amdgcn_exp2f(p1[r]);
    float ps = 0;
#pragma unroll
    for (int r = 0; r < 16; ++r) ps += p0[r];
#pragma unroll
    for (int r = 0; r < 16; ++r) ps += p1[r];
    { auto rr = __builtin_amdgcn_permlane32_swap(__float_as_uint(ps), __float_as_uint(ps), false, false);
      ps = __uint_as_float(rr[0]) + __uint_as_float(rr[1]); }
    l_reg = l_reg * alpha + ps;
#define PK4(P, BASE, OUT) do { unsigned a0 = cvt_pk_bf16(P[BASE + 0], P[BASE + 1]), a1 = cvt_pk_bf16(P[BASE + 2], P[BASE + 3]);   \
    unsigned b0 = cvt_pk_bf16(P[BASE + 4], P[BASE + 5]), b1 = cvt_pk_bf16(P[BASE + 6], P[BASE + 7]);                              \
    auto r0 = __builtin_amdgcn_permlane32_swap(a0, b0, false, false); auto r1 = __builtin_amdgcn_permlane32_swap(a1, b1, false, false); \
    u32x4 w = {r0[0], r1[0], r0[1], r1[1]}; OUT = *reinterpret_cast<bf16x8*>(&w); } while (0)
    PK4(p0, 0, pa0); PK4(p0, 8, pa1); PK4(p1, 0, pa2); PK4(p1, 8, pa3);
#undef PK4
}
#ifndef MLA_SD
#define MLA_SD 1
#endif
#ifndef MLA_NQL
#define MLA_NQL 4
#endif
template <int MLA>
__device__ __forceinline__ void qkt(f32x16& p0, f32x16& p1, const char* Ks, const char* Krs, const bf16x8* qr, const char* qrl, int r32, int hi) {
    constexpr int NQL = MLA ? MLA_NQL : 0;
    p0 = f32x16{}; p1 = f32x16{};
#pragma unroll
    for (int d0 = 0; d0 < 8; ++d0) { const int cb = (d0 * 16 + hi * 8) * 2;
        const bf16x8 b0 = *reinterpret_cast<const bf16x8*>(Ks + KSWZ(r32, cb));
        const bf16x8 b1 = *reinterpret_cast<const bf16x8*>(Ks + KSWZ(32 + r32, cb));
        bf16x8 qf; if (d0 < NQL) qf = *reinterpret_cast<const bf16x8*>(qrl + (4 + d0) * 1024); else qf = qr[d0 - NQL];
        p0 = __builtin_amdgcn_mfma_f32_32x32x16_bf16(b0, qf, p0, 0, 0, 0);
        p1 = __builtin_amdgcn_mfma_f32_32x32x16_bf16(b1, qf, p1, 0, 0, 0); }
    if constexpr (MLA) {
#pragma unroll
        for (int d0 = 0; d0 < 4; ++d0) { const int cb = (d0 * 16 + hi * 8) * 2;
            const bf16x8 b0 = *reinterpret_cast<const bf16x8*>(Krs + KRSWZ(r32, cb));
            const bf16x8 b1 = *reinterpret_cast<const bf16x8*>(Krs + KRSWZ(32 + r32, cb));
            const bf16x8 qf = *reinterpret_cast<const bf16x8*>(qrl + d0 * 1024);
            p0 = __builtin_amdgcn_mfma_f32_32x32x16_bf16(b0, qf, p0, 0, 0, 0);
            p1 = __builtin_amdgcn_mfma_f32_32x32x16_bf16(b1, qf, p1, 0, 0, 0); }
    }
}
__device__ __forceinline__ int v_st(int k, int c) { const int kk = (k & ~0xC) | ((k & 4) << 1) | ((k & 8) >> 1); return ((kk >> 3) * 4 + (c >> 5)) * 512 + ((kk & 7) * 32 + (c & 31)) * 2; }
__device__ __forceinline__ int v_rd_base(int lane) { return ((lane & 3) << 3) | (((lane >> 2) & 3) << 6) | (((lane >> 4) & 1) << 5) | (((lane >> 5) & 1) << 8); }
constexpr int v_rd_off(int d0, int ks, int half) { return d0 * 512 + ks * 4096 + half * 2048; }
template <int OFF> __device__ __forceinline__ s16x4 tr_read(int vb) {
    s16x4 r; asm volatile("ds_read_b64_tr_b16 %0, %1 offset:%2" : "=&v"(r) : "v"(vb), "i"(OFF) : "memory"); return r;
}
template <int D0> __device__ __forceinline__ void pv_one(f32x16& od, int vb, bf16x8 pa0, bf16x8 pa1, bf16x8 pa2, bf16x8 pa3) {
    const s16x4 l0 = tr_read<v_rd_off(D0, 0, 0)>(vb), h0 = tr_read<v_rd_off(D0, 0, 1)>(vb), l1 = tr_read<v_rd_off(D0, 1, 0)>(vb), h1 = tr_read<v_rd_off(D0, 1, 1)>(vb);
    const s16x4 l2 = tr_read<v_rd_off(D0, 2, 0)>(vb), h2 = tr_read<v_rd_off(D0, 2, 1)>(vb), l3 = tr_read<v_rd_off(D0, 3, 0)>(vb), h3 = tr_read<v_rd_off(D0, 3, 1)>(vb);
    asm volatile("s_waitcnt lgkmcnt(0)" ::: "memory"); SBAR();
#define PKV(L, H) (bf16x8){L[0], L[1], L[2], L[3], H[0], H[1], H[2], H[3]}
    od = __builtin_amdgcn_mfma_f32_32x32x16_bf16(PKV(l0, h0), pa0, od, 0, 0, 0);
    od = __builtin_amdgcn_mfma_f32_32x32x16_bf16(PKV(l1, h1), pa1, od, 0, 0, 0);
    od = __builtin_amdgcn_mfma_f32_32x32x16_bf16(PKV(l2, h2), pa2, od, 0, 0, 0);
    od = __builtin_amdgcn_mfma_f32_32x32x16_bf16(PKV(l3, h3), pa3, od, 0, 0, 0);
#undef PKV
}
__device__ __forceinline__ void pv_d0(f32x16* o, int vb, bf16x8 pa0, bf16x8 pa1, bf16x8 pa2, bf16x8 pa3) {
    pv_one<0>(o[0], vb, pa0, pa1, pa2, pa3); pv_one<1>(o[1], vb, pa0, pa1, pa2, pa3); pv_one<2>(o[2], vb, pa0, pa1, pa2, pa3); pv_one<3>(o[3], vb, pa0, pa1, pa2, pa3);
}

template <int MLA>
__device__ __forceinline__ void attn_unit(const bf16* __restrict__ Qn, const bf16* __restrict__ Qr, int ldq, const bf16* __restrict__ Kn, const bf16* __restrict__ Vn, int ldk,
                                          const bf16* __restrict__ Kr, bf16* __restrict__ O, int ldo, int seq, const float SCALE, char* lds) {
    constexpr int NQL = MLA ? MLA_NQL : 0, SD = MLA ? MLA_SD : 2;
    const int tid = threadIdx.x, wid = tid >> 6, lane = tid & 63, r32 = lane & 31, hi = lane >> 5;
    char* V_lds = lds + OFF_V; char* K_lds = lds + OFF_K; char* KR_lds = lds + OFF_KR;
    float m_reg = -1e30f, l_reg = 0; f32x16 o[4] = {}; bf16x8 qr[NQL < 8 ? 8 - NQL : 1];
    char* qrl = lds + OFF_QR + wid * 8192 + lane * 16;
    const bf16* Qw = Qn + (long)(wid * QBLK + r32) * ldq + hi * 8;
#pragma unroll
    for (int d0 = 0; d0 < 8; ++d0) { if (d0 < NQL) *(bf16x8*)(qrl + (4 + d0) * 1024) = ld8(Qw + d0 * 16); else qr[d0 - NQL] = ld8(Qw + d0 * 16); }
    if constexpr (MLA) { const bf16* Qx = Qr + (long)(wid * QBLK + r32) * ldq + hi * 8;
        *(bf16x8*)(qrl) = ld8(Qx); *(bf16x8*)(qrl + 1024) = ld8(Qx + 16); *(bf16x8*)(qrl + 2048) = ld8(Qx + 128); *(bf16x8*)(qrl + 3072) = ld8(Qx + 144); }
    const int sr = tid >> 4, sc = (tid & 15) * 8, vst0 = v_st(sr, sc), vst1 = v_st(32 + sr, sc);
    const int krr = tid >> 3, krc = (tid & 7) * 8;
    const int vb0 = (int)(uintptr_t)V_lds + v_rd_base(lane);
    struct { bf16x8 vs0, vs1, ks0, ks1, kr; } sr_[SD];
#define SLOAD(i, k0) do { sr_[i].vs0 = ld8(&Vn[(long)((k0) + sr) * ldk + sc]); sr_[i].vs1 = ld8(&Vn[(long)((k0) + 32 + sr) * ldk + sc]); \
    sr_[i].ks0 = ld8(&Kn[(long)((k0) + sr) * ldk + sc]); sr_[i].ks1 = ld8(&Kn[(long)((k0) + 32 + sr) * ldk + sc]); \
    if constexpr (MLA) sr_[i].kr = ld8(&Kr[(long)((k0) + krr) * 64 + krc]); } while (0)
#define SWRITE(b, i) do { *(bf16x8*)(V_lds + (b) * SHM_V + vst0) = sr_[i].vs0; *(bf16x8*)(V_lds + (b) * SHM_V + vst1) = sr_[i].vs1; { const int kc = sc * 2; \
    *(bf16x8*)(K_lds + (b) * SHM_K + KSWZ(sr, kc)) = sr_[i].ks0; *(bf16x8*)(K_lds + (b) * SHM_K + KSWZ(32 + sr, kc)) = sr_[i].ks1; } \
    if constexpr (MLA) *(bf16x8*)(KR_lds + (b) * SHM_KR + KRSWZ(krr, krc * 2)) = sr_[i].kr; } while (0)
#define SWAIT() do { if constexpr (SD == 1) asm volatile("s_waitcnt vmcnt(0)" ::: "memory"); else if constexpr (MLA) asm volatile("s_waitcnt vmcnt(5)" ::: "memory"); else asm volatile("s_waitcnt vmcnt(4)" ::: "memory"); } while (0)
#define RESC(a) do { if (__any((a) < 1.f)) { _Pragma("unroll") for (int d = 0; d < 4; ++d) _Pragma("unroll") for (int r = 0; r < 16; ++r) o[d][r] *= (a); } } while (0)
    f32x16 pA0, pA1, pB0, pB1; float mnA, mnB, alA, alB; bf16x8 pa0, pa1, pa2, pa3; const int NT = seq / KVBLK;
    constexpr int SE = 0, SO = SD - 1;
    SLOAD(SE, 0); asm volatile("s_waitcnt vmcnt(0)" ::: "memory"); SWRITE(0, SE); __syncthreads();
    qkt<MLA>(pA0, pA1, K_lds, KR_lds, qr, qrl, r32, hi); partialSM(pA0, pA1, m_reg, mnA, alA, SCALE);
    SLOAD(SO, KVBLK); if constexpr (SD == 2) { if (2 < NT) SLOAD(SE, 2 * KVBLK); }
    SWAIT(); SWRITE(1, SO); __syncthreads();
    for (int j = 1; j + 1 < NT; j += 2) {
        SBAR(); qkt<MLA>(pB0, pB1, K_lds + SHM_K, KR_lds + SHM_KR, qr, qrl, r32, hi);
        finishSM(pA0, pA1, alA, l_reg, pa0, pa1, pa2, pa3); SBAR();
        SLOAD(SO, (j + SD) * KVBLK); SBAR();
        pv_d0(o, vb0, pa0, pa1, pa2, pa3); partialSM(pB0, pB1, m_reg, mnB, alB, SCALE);
        __syncthreads(); SWAIT(); SWRITE(0, SE);
        RESC(alB); __syncthreads();
        SBAR(); qkt<MLA>(pA0, pA1, K_lds, KR_lds, qr, qrl, r32, hi);
        finishSM(pB0, pB1, alB, l_reg, pa0, pa1, pa2, pa3); SBAR();
        if (SD == 1 || j + 3 < NT) SLOAD(SE, (j + 1 + SD) * KVBLK); SBAR();
        pv_d0(o, vb0 + SHM_V, pa0, pa1, pa2, pa3); partialSM(pA0, pA1, m_reg, mnA, alA, SCALE);
        __syncthreads(); SWAIT(); SWRITE(1, SO);
        RESC(alA); __syncthreads();
    }
    SBAR(); qkt<MLA>(pB0, pB1, K_lds + SHM_K, KR_lds + SHM_KR, qr, qrl, r32, hi);
    finishSM(pA0, pA1, alA, l_reg, pa0, pa1, pa2, pa3); SBAR();
    pv_d0(o, vb0, pa0, pa1, pa2, pa3); partialSM(pB0, pB1, m_reg, mnB, alB, SCALE);
    __syncthreads(); RESC(alB);
    finishSM(pB0, pB1, alB, l_reg, pa0, pa1, pa2, pa3); SBAR();
    pv_d0(o, vb0 + SHM_V, pa0, pa1, pa2, pa3);
    const float rl = __builtin_amdgcn_rcpf(l_reg);
    bf16* Ow = O + (long)(wid * QBLK + r32) * ldo + 4 * hi;
#pragma unroll
    for (int d0 = 0; d0 < 4; ++d0)
#pragma unroll
        for (int g = 0; g < 4; ++g) { u32x2 w; w.x = cvt_pk_bf16(o[d0][4 * g] * rl, o[d0][4 * g + 1] * rl); w.y = cvt_pk_bf16(o[d0][4 * g + 2] * rl, o[d0][4 * g + 3] * rl);
            *(u32x2*)(Ow + 32 * d0 + 8 * g) = w; }
    __syncthreads();
#undef SLOAD
#undef SWRITE
#undef SWAIT
#undef RESC
}
}
static_assert(att::LDS_ATT <= RING_BYTES, "attention LDS");

__device__ __forceinline__ void p4_attn0(const Ctx& C) {
    const bf16* proj = (const bf16*)(C.ws + WS_PROJ); bf16* mix = (bf16*)(C.ws + WS_MIX);
    const float scale = 0.08838834764831845f;
    for (int u = C.vcu; u < 512 + 32; u += C.G) {
        int b, h, row0, seq;
        if (u < 512) { const int pair = u >> 6, w = u & 63; b = pair >> 1; h = (pair & 1) * 4 + (w >> 4); row0 = b * RPB + CL + 256 * (w & 15); seq = RPB; }
        else { const int v = u - 512; b = v >> 3; h = v & 7; row0 = b * RPB; seq = CL; }
        const int kvh = h >> 2; const bf16* kb = proj + (size_t)b * RPB * A_IN;
        att::attn_unit<0>(proj + (size_t)row0 * A_IN + 3072 + 128 * h, nullptr, A_IN, kb + 4096 + 128 * kvh, kb + 4352 + 128 * kvh, A_IN, nullptr,
                          mix + (size_t)row0 * DM + 1024 + 128 * h, DM, seq, scale, (char*)C.lds);
    }
}

template <int L>
__device__ __forceinline__ void p_mixer_ln(const Ctx& C, const Args& a) {
    const float* mod = (const float*)(C.ws + WS_MOD) + (size_t)L * 5 * 12288; float* X = (float*)(C.ws + WS_X);
    const bf16* y1 = (const bf16*)(C.ws + (L == 0 ? WS_Y1_0 : WS_Y1_1)); bf16* U = (bf16*)(C.ws + WS_U); bf16* ULO = (bf16*)(C.ws + WS_ULO);
    const float* lng = a.in[I_LNG] + (size_t)(L * 2 + 0) * DM; const float* lnb = a.in[I_LNB] + (size_t)(L * 2 + 0) * DM;
    for (int r = C.gw; r < MROWS; r += C.ngw) {
        int b, p; row_info(r, b, p); const bool isctx = p < CL; if (L == 1 && isctx) continue;
        const float* mr = mod + (size_t)(isctx ? 4 : b) * 12288;
        const float* xo = (L == 0) ? in_row(a, b, p) : X + (size_t)r * DM;
        f32x4 t[8]; float s = 0.f;
#pragma unroll
        for (int j = 0; j < 8; ++j) { const int e = 4 * (C.lane + 64 * j); const f32x4 x = *(const f32x4*)(xo + e), g = *(const f32x4*)(mr + 4096 + e); const u32x2 yw = *(const u32x2*)(y1 + (size_t)r * DM + e);
            const f32x4 y = {bf_lo(yw.x), bf_hi(yw.x), bf_lo(yw.y), bf_hi(yw.y)}; t[j] = x * DN_ALPHA + g * y; s += (t[j][0] + t[j][1]) + (t[j][2] + t[j][3]); }
        const float mean = wave_sum(s) * (1.f / DM); float s2 = 0.f;
#pragma unroll
        for (int j = 0; j < 8; ++j) { t[j] = t[j] - mean; s2 += (t[j][0] * t[j][0] + t[j][1] * t[j][1]) + (t[j][2] * t[j][2] + t[j][3] * t[j][3]); }
        const float rstd = 1.f / sqrtf(wave_sum(s2) * (1.f / DM) + LN_EPS);
#pragma unroll
        for (int j = 0; j < 8; ++j) { const int e = 4 * (C.lane + 64 * j); const f32x4 xn = t[j] * rstd * *(const f32x4*)(lng + e) + *(const f32x4*)(lnb + e);
            *(f32x4*)(X + (size_t)r * DM + e) = xn;
            const f32x4 v = xn * (*(const f32x4*)(mr + 8192 + e) + 1.f) + *(const f32x4*)(mr + 6144 + e);
            u32x2 w; w.x = cvt_pk_bf16(v[0], v[1]); w.y = cvt_pk_bf16(v[2], v[3]); *(u32x2*)(U + (size_t)r * DM + e) = w;
            u32x2 l; l.x = cvt_pk_bf16(v[0] - bf_lo(w.x), v[1] - bf_hi(w.x)); l.y = cvt_pk_bf16(v[2] - bf_lo(w.y), v[3] - bf_hi(w.y)); *(u32x2*)(ULO + (size_t)r * DM + e) = l; }
    }
}

struct EpiLogits {
    float* O;
    __device__ __forceinline__ void operator()(const f32x4 (&acc)[2][2][4][2], const pg8::Unit& u, int wr, int wc, int fr, int fq) const {
        const int row0 = u.pm * 256 + wr * 64 + fr, col0 = wc * 32 + 8 * fq;
#pragma unroll
        for (int ai = 0; ai < 2; ++ai)
#pragma unroll
            for (int m = 0; m < 4; ++m) { float* rowp = O + (size_t)(row0 + ai * 128 + m * 16) * 128 + col0;
                *(f32x4*)(rowp) = acc[ai][0][m][0]; *(f32x4*)(rowp + 4) = acc[ai][0][m][1]; }
    }
};

template <int L>
__device__ __forceinline__ void p_route(const Ctx& C, const Args& a) {
    const float* LOG = (const float*)(C.ws + WS_LOG); int* TE = (int*)(C.ws + WS_TE); float* TW = (float*)(C.ws + WS_TW); int* INV = (int*)(C.ws + WS_INV); int* LIST = (int*)(C.ws + WS_LIST);
    LAS int* hist = (LAS int*)C.lds; LAS int* base = hist + 64; LAS int* rec = hist + 128;
    if (C.tid < 128) hist[C.tid] = 0;
    __syncthreads();
    const float rb = a.in[I_RB][L * NE + C.lane];
    const float NINF = -__builtin_inff();
    int it = 0;
    for (int r = C.gw; r < MROWS; r += C.ngw, ++it) {
        int b, p; row_info(r, b, p); if (L == 1 && p < CL) continue;
        const float lg = (LOG[(size_t)r * 128 + C.lane] + LOG[(size_t)r * 128 + 64 + C.lane]) + (LOG[(size_t)(MROWS + r) * 128 + C.lane] + LOG[(size_t)(MROWS + r) * 128 + 64 + C.lane]);
        const float sc = 1.f / (1.f + __expf(-lg));
        const float sel = sc + rb;
        float m1 = sel; m1 = fmaxf(m1, __shfl_xor(m1, 1)); m1 = fmaxf(m1, __shfl_xor(m1, 2)); m1 = fmaxf(m1, __shfl_xor(m1, 4));
        const unsigned long long eq = __ballot(sel == m1); const int g = C.lane >> 3;
        const unsigned gm = (unsigned)(eq >> (8 * g)) & 0xFFu; const int first = 8 * g + (__ffs(gm) - 1);
        float m2 = (C.lane == first) ? NINF : sel; m2 = fmaxf(m2, __shfl_xor(m2, 1)); m2 = fmaxf(m2, __shfl_xor(m2, 2)); m2 = fmaxf(m2, __shfl_xor(m2, 4));
        const float gs = m1 + m2;
        int grank = 0;
#pragma unroll
        for (int q = 0; q < 8; ++q) { const float o = __shfl(gs, 8 * q); grank += (o > gs || (o == gs && q < g)) ? 1 : 0; }
        const bool gsel = grank < 4;
        const float ms = gsel ? sel : NINF;
        int rank = 0;
#pragma unroll
        for (int q = 0; q < 64; ++q) { const float o = __shfl(ms, q); rank += (o > ms || (o == ms && q < C.lane)) ? 1 : 0; }
        const bool chosen = gsel && rank < 6;
        const float wsum = wave_sum(chosen ? sc : 0.f);
        if (chosen) {
            const int lr = atomicAdd((int*)&hist[C.lane], 1);
            rec[((C.wave * 12 + it) * 8 + rank) * 2] = C.lane; rec[((C.wave * 12 + it) * 8 + rank) * 2 + 1] = lr;
            TW[(size_t)r * 8 + rank] = sc / wsum * 2.5f;
        }
    }
    __syncthreads();
    if (C.tid < 64) { const int h = hist[C.tid]; base[C.tid] = h ? (int)__hip_atomic_fetch_add(C.ctl + CW_CNT + L * 64 + C.tid, (unsigned)h, RLX_AGENT) : 0; }
    __syncthreads();
    it = 0;
    for (int r = C.gw; r < MROWS; r += C.ngw, ++it) {
        int b, p; row_info(r, b, p); if (L == 1 && p < CL) continue;
        if (C.lane < 6) { const int e = rec[((C.wave * 12 + it) * 8 + C.lane) * 2], lr = rec[((C.wave * 12 + it) * 8 + C.lane) * 2 + 1];
            TE[(size_t)r * 8 + C.lane] = e; INV[(size_t)r * 8 + C.lane] = lr + base[e]; LIST[(size_t)e * LCAP + lr + base[e]] = r; }
    }
    __syncthreads();
}

struct MoeTab { LAS int* cnt; LAS int* bstart; LAS int* blke; };
template <int L>
__device__ __forceinline__ MoeTab moe_tables(const Ctx& C) {
    MoeTab T; T.cnt = (LAS int*)(C.lds + MOE_TAB_OFF); T.bstart = T.cnt + 64; T.blke = T.cnt + 192;
    __syncthreads();
    if (C.tid < 64) T.cnt[C.tid] = (int)__hip_atomic_load(C.ctl + CW_CNT + L * 64 + C.tid, RLX_AGENT);
    __syncthreads();
    if (C.tid == 0) { int acc = 0; for (int e = 0; e < NE; ++e) { T.bstart[e] = acc; const int nb = (T.cnt[e] + 255) >> 8; for (int q = 0; q < nb && acc + q < XS_BLK; ++q) T.blke[acc + q] = e; acc += nb; if (acc > XS_BLK) acc = XS_BLK; }
        T.bstart[NE] = acc; }
    __syncthreads();
    return T;
}
struct MoeSched {
    MoeTab T; const int* list; int nblk_r, nsh, ncol, G, c, sh_lat_only, gather;
    __device__ __forceinline__ bool next(int i, pg8::Unit& u) const {
        const int total = (nblk_r + nsh) * ncol; const long Lq = (long)i * G + c; if (Lq >= total) return false;
        const int w = pg8::xcd_remap((int)Lq, total); const int b = w / ncol, j = w - b * ncol;
        int e, pm;
        if (b < nblk_r) { pm = b; e = T.blke[b]; } else { int sb = b - nblk_r; if (sh_lat_only) sb = 17 * (sb >> 4) + 1 + (sb & 15); pm = XS_BLK + sb; e = NE; }
        u.pm = pm; u.pn = e * ncol + j; return true;
    }
    __device__ __forceinline__ unsigned rowid(const pg8::Unit& u, int h, int R) const {
        if (!gather) return (unsigned)(u.pm * 256 + h * 128 + R);
        if (u.pm >= XS_BLK) return (unsigned)((u.pm - XS_BLK) * 256 + h * 128 + R);
        const int e = T.blke[u.pm], idx = (u.pm - T.bstart[e]) * 256 + h * 128 + R;
        return idx < T.cnt[e] ? (unsigned)list[(size_t)e * LCAP + idx] : 0u;
    }
};
struct EpiSwiGLU {
    bf16* H;
    __device__ __forceinline__ void operator()(const f32x4 (&acc)[2][2][4][2], const pg8::Unit& u, int wr, int wc, int fr, int fq) const {
        const int row0 = u.pm * 256 + wr * 64 + fr, col0 = (u.pn & 3) * 128 + wc * 32 + 8 * fq;
#pragma unroll
        for (int ai = 0; ai < 2; ++ai)
#pragma unroll
            for (int m = 0; m < 4; ++m) { float h[8];
#pragma unroll
                for (int n = 0; n < 2; ++n)
#pragma unroll
                    for (int i = 0; i < 4; ++i) { const float g = acc[ai][0][m][n][i], up = acc[ai][1][m][n][i]; h[4 * n + i] = g * __builtin_amdgcn_rcpf(1.f + __expf(-g)) * up; }
                u32x4 w; w.x = cvt_pk_bf16(h[0], h[1]); w.y = cvt_pk_bf16(h[2], h[3]); w.z = cvt_pk_bf16(h[4], h[5]); w.w = cvt_pk_bf16(h[6], h[7]);
                *(u32x4*)(H + (size_t)(row0 + ai * 128 + m * 16) * FF + col0) = w; }
    }
};
struct EpiDown {
    bf16* Y;
    __device__ __forceinline__ void operator()(const f32x4 (&acc)[2][2][4][2], const pg8::Unit& u, int wr, int wc, int fr, int fq) const {
        const int row0 = u.pm * 256 + wr * 64 + fr, col0 = (u.pn & 7) * 256 + wc * 32 + 8 * fq;
#pragma unroll
        for (int ai = 0; ai < 2; ++ai)
#pragma unroll
            for (int m = 0; m < 4; ++m) { bf16* rowp = Y + (size_t)(row0 + ai * 128 + m * 16) * DM + col0;
#pragma unroll
                for (int bj = 0; bj < 2; ++bj) { const f32x4 v0 = acc[ai][bj][m][0], v1 = acc[ai][bj][m][1];
                    u32x4 w; w.x = cvt_pk_bf16(v0[0], v0[1]); w.y = cvt_pk_bf16(v0[2], v0[3]); w.z = cvt_pk_bf16(v1[0], v1[1]); w.w = cvt_pk_bf16(v1[2], v1[3]);
                    *(u32x4*)(rowp + bj * 128) = w; } }
    }
};

template <int L>
__device__ __forceinline__ void p_combine(const Ctx& C, const Args& a) {
    const float* mod = (const float*)(C.ws + WS_MOD) + (size_t)L * 5 * 12288; float* X = (float*)(C.ws + WS_X);
    const bf16* Y = (const bf16*)(C.ws + WS_Y); const int* INV = (const int*)(C.ws + WS_INV); const float* TW = (const float*)(C.ws + WS_TW);
    bf16* UM = (bf16*)(C.ws + WS_UM); const int* TE = (const int*)(C.ws + WS_TE);
    const MoeTab T = moe_tables<L>(C);
    const float* lng = a.in[I_LNG] + (size_t)(L * 2 + 1) * DM; const float* lnb = a.in[I_LNB] + (size_t)(L * 2 + 1) * DM;
    for (int r = C.gw; r < MROWS; r += C.ngw) {
        int b, p; row_info(r, b, p); const bool isctx = p < CL; if (L == 1 && isctx) continue;
        const float* mr = mod + (size_t)(isctx ? 4 : b) * 12288;
        int slot = 0; float wt = 0.f;
        if (C.lane < 6) { slot = T.bstart[TE[(size_t)r * 8 + C.lane]] * 256 + INV[(size_t)r * 8 + C.lane]; wt = TW[(size_t)r * 8 + C.lane]; }
        f32x4 f[8];
        { const bf16* ys = Y + ((size_t)XS_BLK * 256 + r) * DM;
#pragma unroll
          for (int j = 0; j < 8; ++j) { const u32x2 yw = *(const u32x2*)(ys + 4 * (C.lane + 64 * j)); f[j] = (f32x4){bf_lo(yw.x), bf_hi(yw.x), bf_lo(yw.y), bf_hi(yw.y)}; } }
#pragma unroll
        for (int k = 0; k < 6; ++k) { const int s = __shfl(slot, k); const float w = __shfl(wt, k); const bf16* ys = Y + (size_t)s * DM;
#pragma unroll
            for (int j = 0; j < 8; ++j) { const u32x2 yw = *(const u32x2*)(ys + 4 * (C.lane + 64 * j)); f[j] += (f32x4){bf_lo(yw.x), bf_hi(yw.x), bf_lo(yw.y), bf_hi(yw.y)} * w; } }
        float s = 0.f;
#pragma unroll
        for (int j = 0; j < 8; ++j) { const int e = 4 * (C.lane + 64 * j); f[j] = *(const f32x4*)(X + (size_t)r * DM + e) * DN_ALPHA + *(const f32x4*)(mr + 10240 + e) * f[j]; s += (f[j][0] + f[j][1]) + (f[j][2] + f[j][3]); }
        const float mean = wave_sum(s) * (1.f / DM); float s2 = 0.f;
#pragma unroll
        for (int j = 0; j < 8; ++j) { f[j] = f[j] - mean; s2 += (f[j][0] * f[j][0] + f[j][1] * f[j][1]) + (f[j][2] * f[j][2] + f[j][3] * f[j][3]); }
        const float rstd = 1.f / sqrtf(wave_sum(s2) * (1.f / DM) + LN_EPS);
        float* orow = (L == 0) ? X + (size_t)r * DM : a.out + ((size_t)(b * SEQ + (p - CL))) * DM;
        const float* mn = mod + (size_t)5 * 12288 + (size_t)(isctx ? 4 : b) * 12288;
#pragma unroll
        for (int j = 0; j < 8; ++j) { const int e = 4 * (C.lane + 64 * j); const f32x4 xn = f[j] * rstd * *(const f32x4*)(lng + e) + *(const f32x4*)(lnb + e);
            *(f32x4*)(orow + e) = xn;
            if (L == 0) { const f32x4 v = xn * (*(const f32x4*)(mn + 2048 + e) + 1.f) + *(const f32x4*)(mn + e);
                u32x2 w; w.x = cvt_pk_bf16(v[0], v[1]); w.y = cvt_pk_bf16(v[2], v[3]); *(u32x2*)(UM + (size_t)r * DM + e) = w; } }
    }
}

__device__ __forceinline__ void p13_mla_norm(const Ctx& C, const Args& a) {
    const bf16* dp = (const bf16*)(C.ws + WS_DOWNP); bf16* cq = (bf16*)(C.ws + WS_CQKV); bf16* ckv = cq + (size_t)MROWS * 512; bf16* kr = (bf16*)(C.ws + WS_KR);
    const f32x2* rope = (const f32x2*)(C.ws + WS_ROPE64);
    const f32x4 qga = *(const f32x4*)(a.in[I_MQG] + 8 * C.lane), qgb = *(const f32x4*)(a.in[I_MQG] + 8 * C.lane + 4);
    const f32x4 kga = *(const f32x4*)(a.in[I_MKVG] + 8 * C.lane), kgb = *(const f32x4*)(a.in[I_MKVG] + 8 * C.lane + 4);
    for (int r = C.gw; r < MROWS; r += C.ngw) {
        int b, p; row_info(r, b, p); const bool isctx = p < CL;
        const bf16* row = dp + (size_t)r * 1280;
#pragma unroll
        for (int part = 0; part < 2; ++part) {
            const u32x4 w = *(const u32x4*)(row + 512 * part + 8 * C.lane);
            float v[8] = {bf_lo(w.x), bf_hi(w.x), bf_lo(w.y), bf_hi(w.y), bf_lo(w.z), bf_hi(w.z), bf_lo(w.w), bf_hi(w.w)};
            float ss = 0.f;
#pragma unroll
            for (int q = 0; q < 8; ++q) ss += v[q] * v[q];
            const float rs = 1.f / sqrtf(wave_sum(ss) * (1.f / 512.f) + RMS_EPS);
            const f32x4 ga = part ? kga : qga, gb = part ? kgb : qgb;
            u32x4 o; o.x = cvt_pk_bf16(v[0] * rs * ga[0], v[1] * rs * ga[1]); o.y = cvt_pk_bf16(v[2] * rs * ga[2], v[3] * rs * ga[3]);
            o.z = cvt_pk_bf16(v[4] * rs * gb[0], v[5] * rs * gb[1]); o.w = cvt_pk_bf16(v[6] * rs * gb[2], v[7] * rs * gb[3]);
            *(u32x4*)((part ? ckv : cq) + (size_t)r * 512 + 8 * C.lane) = o;
        }
        if (C.lane < 32) { const float x1 = bf2f(row[1024 + C.lane]), x2 = bf2f(row[1056 + C.lane]);
            f32x2 cs = {1.f, 0.f}; if (!isctx) cs = rope[(size_t)(p - CL) * 32 + C.lane];
            kr[(size_t)r * 64 + C.lane] = (bf16)f2bf(x1 * cs.x - x2 * cs.y); kr[(size_t)r * 64 + 32 + C.lane] = (bf16)f2bf(x2 * cs.x + x1 * cs.y); }
    }
}

struct UpSched {
    int G, c;
    __device__ __forceinline__ bool next(int i, pg8::Unit& u) const {
        constexpr int NQ = 64 * 12, NKV = MT * 16; const long Lq = (long)i * G + c; if (Lq >= NQ + NKV) return false;
        const int w = pg8::xcd_remap((int)Lq, NQ + NKV); int pm, pn;
        if (w < NQ) { pg8::tile_of(w, 64, 12, pm, pn); pm = 17 * (pm >> 4) + 1 + (pm & 15); }
        else { pg8::tile_of(w - NQ, MT, 16, pm, pn); pm += MT; pn += 12; }
        u.pm = pm; u.pn = pn; return true;
    }
    __device__ __forceinline__ unsigned rowid(const pg8::Unit& u, int h, int R) const { return (unsigned)(u.pm * 256 + h * 128 + R); }
};
struct EpiUp {
    bf16* QB; bf16* KVB; const f32x2* rope;
    __device__ __forceinline__ void operator()(const f32x4 (&acc)[2][2][4][2], const pg8::Unit& u, int wr, int wc, int fr, int fq) const {
        const bool isq = u.pn < 12; const int rowt = isq ? u.pm : u.pm - MT;
        const int row0 = rowt * 256 + wr * 64 + fr, cw = wc * 32 + 8 * fq;
        bf16* base = isq ? QB + 256 * u.pn + cw : KVB + 256 * (u.pn - 12) + cw; const int ldc = isq ? 3072 : 4096;
        const bool dorope = isq && u.pn >= 8;
#pragma unroll
        for (int ai = 0; ai < 2; ++ai)
#pragma unroll
            for (int m = 0; m < 4; ++m) { const int row = row0 + ai * 128 + m * 16; bf16* rowp = base + (size_t)row * ldc;
                f32x4 a0 = acc[ai][0][m][0], a1 = acc[ai][0][m][1], b0 = acc[ai][1][m][0], b1 = acc[ai][1][m][1];
                if (dorope) { const int bb = row / RPB, pos = row - bb * RPB - CL; const f32x2* rp = rope + (size_t)pos * 32 + 8 * fq;
#pragma unroll
                    for (int i = 0; i < 4; ++i) { const f32x2 c0 = rp[i], c1 = rp[4 + i];
                        const float x1 = a0[i], x2 = b0[i]; a0[i] = x1 * c0.x - x2 * c0.y; b0[i] = x2 * c0.x + x1 * c0.y;
                        const float y1 = a1[i], y2 = b1[i]; a1[i] = y1 * c1.x - y2 * c1.y; b1[i] = y2 * c1.x + y1 * c1.y; } }
                u32x4 w; w.x = cvt_pk_bf16(a0[0], a0[1]); w.y = cvt_pk_bf16(a0[2], a0[3]); w.z = cvt_pk_bf16(a1[0], a1[1]); w.w = cvt_pk_bf16(a1[2], a1[3]);
                *(u32x4*)(rowp) = w;
                w.x = cvt_pk_bf16(b0[0], b0[1]); w.y = cvt_pk_bf16(b0[2], b0[3]); w.z = cvt_pk_bf16(b1[0], b1[1]); w.w = cvt_pk_bf16(b1[2], b1[3]);
                *(u32x4*)(rowp + 128) = w; }
    }
};

__device__ __forceinline__ void p15_attn1(const Ctx& C) {
    const bf16* qb = (const bf16*)(C.ws + WS_QB); const bf16* kvb = (const bf16*)(C.ws + WS_KVB); const bf16* kr = (const bf16*)(C.ws + WS_KR); bf16* attb = (bf16*)(C.ws + WS_ATT);
    const float scale = 0.07216878364870323f;
    for (int u = C.vcu; u < 1024; u += C.G) {
        const int bh = u >> 4, qblk = u & 15, b = bh >> 4, h = bh & 15, row0 = b * RPB + CL + 256 * qblk;
        const bf16* kn = kvb + (size_t)b * RPB * 4096 + 256 * h;
        att::attn_unit<1>(qb + (size_t)row0 * 3072 + 128 * h, qb + (size_t)row0 * 3072 + 2048 + 256 * (h >> 2) + 32 * (h & 3), 3072, kn, kn + 128, 4096, kr + (size_t)b * RPB * 64,
                          attb + (size_t)row0 * DM + 128 * h, DM, RPB, scale, (char*)C.lds);
    }
}

constexpr int NPH = 22;
__global__ void __launch_bounds__(512, 2) fwd(Args args) {
    extern __shared__ __attribute__((aligned(16))) unsigned char lds_raw[];
    Ctx C;
    C.lds = (LAS unsigned char*)lds_raw;
    C.tid = threadIdx.x; C.lane = C.tid & 63; C.wave = __builtin_amdgcn_readfirstlane(C.tid >> 6);
    C.G = gridDim.x; C.bid = blockIdx.x; C.vcu = (C.G % 8 == 0) ? (C.bid % 8) * (C.G / 8) + C.bid / 8 : C.bid;
    C.gw = C.bid * 8 + C.wave; C.ngw = C.G * 8;
    C.ws = args.ws; C.ctl = (unsigned*)(args.ws + WS_CTL);
    volatile LAS unsigned* MISC = (volatile LAS unsigned*)(C.lds + MISC_OFF);
    for (int u = C.tid; u < (LDS_BYTES - RING_BYTES) / 4; u += 512) ((LAS unsigned*)(C.lds + RING_BYTES))[u] = 0u;
    __syncthreads();
    XcdBarrier bar; bar.bar = C.ctl + CW_BAR; bar.x = 0; bar.st = nullptr;
    if (!MK_PER_PHASE) bar = xcd_barrier_post(C.ctl + CW_BAR, MISC + 8);
    const int lo = args.ph_lo, hi = args.ph_hi;
    unsigned char* ws = C.ws;
#ifndef PHMASK
#define PHMASK 0xFFFFFFFFu
#endif
#define IN(k) (((PHMASK >> (k)) & 1u) && lo <= (k) && (k) < hi)
#define SEAM(k) do { if (IN(k) && IN((k) + 1)) xcd_barrier(bar); } while (0)
#ifndef REP_MASK
#define REP_MASK 0u
#endif
#define REP2(k) ((((REP_MASK) >> (k)) & 1u) != 0u)
#define RUN(k, ...) do { if (IN(k)) { { __VA_ARGS__ } if (REP2(k)) { xcd_barrier(bar); { __VA_ARGS__ } } } } while (0)

    RUN(0, p0_prologue(C, args););
    SEAM(0);
    RUN(1, p1_modulate0(C, args););
    SEAM(1);
    RUN(2,        pg8::Gemm g{(const bf16*)(ws + WS_UM), (const bf16*)(ws + WS_W_IN), DM}; DenseSched S{MT, A_IN / 256, C.G, C.bid, 0, 0, 0};
        EpiStoreBf16 E{(bf16*)(ws + WS_PROJ), A_IN}; pg8::gemm_phase(C.lds, g, S, E);
    );
    SEAM(2);
    if (IN(3)) p3_qk_conv(C, args);
    SEAM(3);
    RUN(4, p4_attn0(C););
    SEAM(4);
    RUN(5,        pg8::Gemm g{(const bf16*)(ws + WS_MIX), (const bf16*)(ws + WS_W_OUT0), DM}; DenseSched S{MT, DM / 256, C.G, C.bid, 0, 0, 0};
        EpiStoreBf16 E{(bf16*)(ws + WS_Y1_0), DM}; pg8::gemm_phase(C.lds, g, S, E);
    );
    SEAM(5);
    if (IN(6)) p_mixer_ln<0>(C, args);
    SEAM(6);
    RUN(7,        pg8::Gemm g{(const bf16*)(ws + WS_U), (const bf16*)(ws + WS_W_RT), DM}; DenseSched S{2 * MT, 1, C.G, C.bid, 0, 0, 0};
        EpiLogits E{(float*)(ws + WS_LOG)}; pg8::gemm_phase(C.lds, g, S, E);
    );
    SEAM(7);
    if (IN(8)) p_route<0>(C, args);
    SEAM(8);
    RUN(9,
        const MoeTab T = moe_tables<0>(C);
        pg8::Gemm g{(const bf16*)(ws + WS_U), (const bf16*)(ws + WS_W_GU), DM};
        MoeSched S{T, (const int*)(ws + WS_LIST), T.bstart[NE], SH_BLK, 4, C.G, C.bid, 0, 1};
        EpiSwiGLU E{(bf16*)(ws + WS_H)}; pg8::gemm_phase(C.lds, g, S, E);
    );
    SEAM(9);
    RUN(10,
        const MoeTab T = moe_tables<0>(C);
        pg8::Gemm g{(const bf16*)(ws + WS_H), (const bf16*)(ws + WS_W_D), FF};
        MoeSched S{T, nullptr, T.bstart[NE], SH_BLK, 8, C.G, C.bid, 0, 0};
        EpiDown E{(bf16*)(ws + WS_Y)}; pg8::gemm_phase(C.lds, g, S, E);
    );
    SEAM(10);
    if (IN(11)) p_combine<0>(C, args);
    SEAM(11);
    RUN(12,
        pg8::Gemm g{(const bf16*)(ws + WS_UM), (const bf16*)(ws + WS_W_DOWN), DM}; DenseSched S{MT, 5, C.G, C.bid, 0, 0, 0};
        EpiStoreBf16 E{(bf16*)(ws + WS_DOWNP), 1280}; pg8::gemm_phase(C.lds, g, S, E);
    );
    SEAM(12);
    RUN(13, p13_mla_norm(C, args););
    SEAM(13);
    RUN(14,
        pg8::Gemm g{(const bf16*)(ws + WS_CQKV), (const bf16*)(ws + WS_W_UQKV), 512}; UpSched S{C.G, C.bid};
        EpiUp E{(bf16*)(ws + WS_QB), (bf16*)(ws + WS_KVB), (const f32x2*)(ws + WS_ROPE64)}; pg8::gemm_phase(C.lds, g, S, E);
    );
    SEAM(14);
    RUN(15, p15_attn1(C););
    SEAM(15);
    RUN(16,
        pg8::Gemm g{(const bf16*)(ws + WS_ATT), (const bf16*)(ws + WS_W_OUT1), DM}; DenseSched S{64, DM / 256, C.G, C.bid, 1, 0, 0};
        EpiStoreBf16 E{(bf16*)(ws + WS_Y1_1), DM}; pg8::gemm_phase(C.lds, g, S, E);
    );
    SEAM(16);
    if (IN(17)) p_mixer_ln<1>(C, args);
    SEAM(17);
    RUN(18,
        pg8::Gemm g{(const bf16*)(ws + WS_U), (const bf16*)(ws + WS_W_RT + (size_t)256 * DM * 2), DM}; DenseSched S{2 * MT, 1, C.G, C.bid, 0, 0, 0};
        EpiLogits E{(float*)(ws + WS_LOG)}; pg8::gemm_phase(C.lds, g, S, E);
    );
    SEAM(18);
    if (IN(19)) p_route<1>(C, args);
    SEAM(19);
    RUN(20,
        const MoeTab T = moe_tables<1>(C);
        pg8::Gemm g{(const bf16*)(ws + WS_U), (const bf16*)(ws + WS_W_GU) + W_GU_L, DM};
        MoeSched S{T, (const int*)(ws + WS_LIST), T.bstart[NE], 64, 4, C.G, C.bid, 1, 1};
        EpiSwiGLU E{(bf16*)(ws + WS_H)}; pg8::gemm_phase(C.lds, g, S, E);
    );
    SEAM(20);
    RUN(21,
        const MoeTab T = moe_tables<1>(C);
        pg8::Gemm g{(const bf16*)(ws + WS_H), (const bf16*)(ws + WS_W_D) + W_D_L, FF};
        MoeSched S{T, nullptr, T.bstart[NE], 64, 8, C.G, C.bid, 1, 0};
        EpiDown E{(bf16*)(ws + WS_Y)}; pg8::gemm_phase(C.lds, g, S, E);
    );
    SEAM(21);
    if (IN(22)) p_combine<1>(C, args);
#undef IN
#undef SEAM
}

extern "C" void kernel_launch(void* const* d_in, const int* in_sizes, int n_in, void* d_out, int out_size, void* d_ws, size_t ws_size, hipStream_t stream) {
    static int grid = 0;
    if (grid == 0) {
        if (n_in != 27 || ws_size < WS_END) { fprintf(stderr, "kernel_launch: n_in %d ws %zu (need %zu)\n", n_in, ws_size, (size_t)WS_END); grid = -1; return; }
        int dev = 0, cus = 0, per_cu = 0;
        if (hipGetDevice(&dev) != hipSuccess || hipDeviceGetAttribute(&cus, hipDeviceAttributeMultiprocessorCount, dev) != hipSuccess) { grid = -1; return; }
        if (hipFuncSetAttribute((const void*)fwd, hipFuncAttributeMaxDynamicSharedMemorySize, LDS_BYTES) != hipSuccess) { fprintf(stderr, "kernel_launch: hipFuncSetAttribute failed\n"); grid = -1; return; }
        if (hipOccupancyMaxActiveBlocksPerMultiprocessor(&per_cu, (const void*)fwd, 512, LDS_BYTES) != hipSuccess || per_cu < 1) fprintf(stderr, "kernel_launch: occupancy query says %d\n", per_cu);
        (void)hipGetLastError();
        grid = cus;
    }
    if (grid < 0) return;
    if (hipMemsetAsync((char*)d_ws + WS_CTL, 0, CTL_ZERO_BYTES, stream) != hipSuccess) return;
    Args a{};
    for (int i = 0; i < 27; ++i) a.in[i] = (const float*)d_in[i];
    a.out = (float*)d_out; a.ws = (unsigned char*)d_ws;
#if MK_PER_PHASE
    for (int k = 0; k <= NPH; ++k) { a.ph_lo = k; a.ph_hi = k + 1; hipLaunchKernelGGL(fwd, dim3(grid), dim3(512), LDS_BYTES, stream, a); }
#else
    a.ph_lo = 0; a.ph_hi = NPH + 1;
    hipLaunchKernelGGL(fwd, dim3(grid), dim3(512), LDS_BYTES, stream, a);
#endif
    const hipError_t le = hipPeekAtLastError();
    if (le != hipSuccess) fprintf(stderr, "kernel_launch: launch failed: %s\n", hipGetErrorName(le));
}
```

```cpp
#include <hip/hip_runtime.h>
#include <cstdio>
#include <cstdint>

#ifndef MK_PER_PHASE
#define MK_PER_PHASE 0
#endif

#define GAS __attribute__((address_space(1)))
#define LAS __attribute__((address_space(3)))
typedef unsigned short bf16;
typedef short bf16x8 __attribute__((ext_vector_type(8)));
typedef short s16x4 __attribute__((ext_vector_type(4)));
typedef float f32x4 __attribute__((ext_vector_type(4)));
typedef float f32x2 __attribute__((ext_vector_type(2)));
typedef float f32x16 __attribute__((ext_vector_type(16)));
typedef unsigned u32x4 __attribute__((ext_vector_type(4)));
typedef unsigned u32x2 __attribute__((ext_vector_type(2)));
#define RLX_AGENT __ATOMIC_RELAXED, __HIP_MEMORY_SCOPE_AGENT
#define LDS_WAIT() asm volatile("s_waitcnt lgkmcnt(0)" ::: "memory")
#define SBAR() __builtin_amdgcn_sched_barrier(0)

__device__ __forceinline__ unsigned cvt_pk_bf16(float lo, float hi) { unsigned r; asm volatile("v_cvt_pk_bf16_f32 %0, %1, %2" : "=v"(r) : "v"(lo), "v"(hi)); return r; }
__device__ __forceinline__ float bf_lo(unsigned w) { return __uint_as_float(w << 16); }
__device__ __forceinline__ float bf_hi(unsigned w) { return __uint_as_float(w & 0xffff0000u); }
__device__ __forceinline__ float bf2f(bf16 v) { return __uint_as_float(((unsigned)v) << 16); }
__device__ __forceinline__ unsigned f2bf(float f) { unsigned u = __float_as_uint(f); return (u + 0x7fffu + ((u >> 16) & 1u)) >> 16; }
__device__ __forceinline__ float wave_sum(float v) {
#pragma unroll
    for (int o = 1; o < 64; o <<= 1) v += __shfl_xor(v, o);
    return v;
}

namespace pg8 {
constexpr int BM = 256, BK = 64, HALF = 128, HTB = HALF * BK * 2, STAGE_BYTES = 8 * HTB, NXCD = 8, WGM = 8;
__host__ __device__ __forceinline__ int lds_byte(int r, int c) { const int st = (r >> 4) * 2 + (c >> 5), rr = r & 15, cc = c & 31, ob = rr * 64 + cc * 2; return st * 1024 + (ob ^ (((ob >> 9) & 1) << 5)); }
__host__ __device__ __forceinline__ void stage_rc(int b, int& R, int& C) { const int st = b / 1024, sb = b % 1024, swz = sb ^ (((sb >> 9) & 1) << 5); R = (st >> 1) * 16 + swz / 64; C = (st & 1) * 32 + (swz % 64) / 2; }
__host__ __device__ __forceinline__ int perm32(int rho) { const int n = rho >> 4, i = rho & 15; return 8 * (i >> 2) + 4 * n + (i & 3); }

struct Unit { int pm, pn; };
struct Gemm { const bf16* A; const bf16* Bt; int K; };

__device__ __forceinline__ int xcd_remap(int wgid, int nwg) { const int q = nwg / NXCD, r = nwg % NXCD, xcd = wgid % NXCD, off = wgid / NXCD; return (xcd < r ? xcd * (q + 1) : r * (q + 1) + (xcd - r) * q) + off; }
__device__ __forceinline__ void tile_of(int wgid, int nM, int nN, int& pm, int& pn) {
    const int nig = WGM * nN, gid = wgid / nig, fm = gid * WGM, gsz = (nM - fm) < WGM ? (nM - fm) : WGM;
    pm = fm + ((wgid % nig) % gsz); pn = (wgid % nig) / gsz;
}

template <class Epi, class Sched, bool ALIGN_EPI = true, bool SP2 = true>
__device__ __forceinline__ void gemm_phase(LAS unsigned char* lds, const Gemm g, const Sched& S, const Epi& E) {
    const int tid = threadIdx.x, wid = __builtin_amdgcn_readfirstlane(tid >> 6), lane = tid & 63, wr = wid >> 2, wc = wid & 3, fr = lane & 15, fq = lane >> 4;
    const int K = g.K, nt = K / BK;
    unsigned voffB[2]; int Ra[2], Ca[2];
#pragma unroll
    for (int i = 0; i < 2; ++i) { int R, C; stage_rc(tid * 16 + i * 8192, R, C); const int Rb = (R & ~31) + perm32(R & 31);
        Ra[i] = R; Ca[i] = C; voffB[i] = (unsigned)(Rb * K + C) * 2u; }
    unsigned goA[2][2], gnA[2][2];
#define PG8_ROWS(dst, unit) do { _Pragma("unroll") for (int _h = 0; _h < 2; ++_h) _Pragma("unroll") for (int _i = 0; _i < 2; ++_i) \
        dst[_h][_i] = (S.rowid(unit, _h, Ra[_i]) * (unsigned)K + (unsigned)Ca[_i]) * 2u; } while (0)
#define PG8_STAGEA(bufoff, kb, offs) do { _Pragma("unroll") for (int _i = 0; _i < 2; ++_i) \
        __builtin_amdgcn_global_load_lds((const unsigned*)(gA + (kb) + (offs)[_i]), (LAS unsigned*)(lds + (bufoff) + ldsw + _i * 8192), 16, 0, 0); } while (0)
    const size_t kstep = (size_t)(BK * 2);
    const size_t hstep = (size_t)HALF * K * 2;
    const size_t tstep = 2 * hstep;
    const unsigned ldsw = (unsigned)wid * 1024u;
    const int aoff = lds_byte(wr * 64 + fr, fq * 8), boff = lds_byte(wc * 32 + fr, fq * 8);
#define PG8_SA(b, h) (((b) * 2 + (h)) * HTB)
#define PG8_SB(b, h) ((4 + (b) * 2 + (h)) * HTB)
#define PG8_STAGE(bufoff, gbase, voff) do { _Pragma("unroll") for (int _i = 0; _i < 2; ++_i) \
        __builtin_amdgcn_global_load_lds((const unsigned*)((const char*)(gbase) + (voff)[_i]), (LAS unsigned*)(lds + (bufoff) + ldsw + _i * 8192), 16, 0, 0); } while (0)
#define PG8_LDA(dst, b, h) do { _Pragma("unroll") for (int m = 0; m < 4; ++m) _Pragma("unroll") for (int k = 0; k < 2; ++k) dst[m][k] = *(const LAS bf16x8*)(lds + PG8_SA(b, h) + aoff + m * 2048 + k * 1024); } while (0)
#define PG8_LDB(dst, b, h) do { _Pragma("unroll") for (int n = 0; n < 2; ++n) _Pragma("unroll") for (int k = 0; k < 2; ++k) dst[n][k] = *(const LAS bf16x8*)(lds + PG8_SB(b, h) + boff + n * 2048 + k * 1024); } while (0)
#define PG8_MMA(ai, bj, At, Bt) do { __builtin_amdgcn_s_setprio(1); _Pragma("unroll") for (int m = 0; m < 4; ++m) _Pragma("unroll") for (int n = 0; n < 2; ++n) _Pragma("unroll") for (int k = 0; k < 2; ++k) \
        acc[ai][bj][m][n] = __builtin_amdgcn_mfma_f32_16x16x32_bf16(Bt[n][k], At[m][k], acc[ai][bj][m][n], 0, 0, 0); __builtin_amdgcn_s_setprio(0); } while (0)
#define PG8_WAIT_V(n) asm volatile("s_waitcnt vmcnt(" #n ")" ::: "memory")
#define PG8_WAIT_L(n) asm volatile("s_waitcnt lgkmcnt(" #n ")" ::: "memory")
#define PG8_BAR __builtin_amdgcn_s_barrier()
#define PG8_SCHED __builtin_amdgcn_sched_barrier(0)
    Unit cur, nxt; int ui = 0;
    if (!S.next(0, cur)) return;
    f32x4 acc[2][2][4][2];
#pragma unroll
    for (int a = 0; a < 2; ++a)
#pragma unroll
        for (int b = 0; b < 2; ++b)
#pragma unroll
            for (int m = 0; m < 4; ++m)
#pragma unroll
                for (int n = 0; n < 2; ++n) acc[a][b][m][n] = (f32x4){0.f, 0.f, 0.f, 0.f};
    bf16x8 At[4][2], B0[2][2], B1[2][2];
    const char* const gA = (const char*)g.A; const char* cB = (const char*)g.Bt + (size_t)cur.pn * tstep;
    PG8_ROWS(goA, cur);
    {
        PG8_STAGE(PG8_SB(0, 0), cB, voffB); PG8_STAGE(PG8_SB(0, 1), cB + hstep, voffB); PG8_STAGEA(PG8_SA(0, 0), 0, goA[0]); PG8_STAGEA(PG8_SA(0, 1), 0, goA[1]);
        if (wr == 1) PG8_BAR;
        PG8_WAIT_V(2); PG8_BAR;
        PG8_STAGE(PG8_SB(1, 0), cB + kstep, voffB); PG8_STAGEA(PG8_SA(1, 0), kstep, goA[0]); PG8_STAGE(PG8_SB(1, 1), cB + hstep + kstep, voffB);
        PG8_WAIT_V(6); PG8_BAR;
    }
    for (;;) {
        const bool has_next = S.next(ui + 1, nxt);
        const char* nB = has_next ? (const char*)g.Bt + (size_t)nxt.pn * tstep : cB;
        if (has_next) PG8_ROWS(gnA, nxt); else { gnA[0][0] = goA[0][0]; gnA[0][1] = goA[0][1]; gnA[1][0] = goA[1][0]; gnA[1][1] = goA[1][1]; }
        for (int t = 0; t < nt; t += 2) {
            const bool last = (t == nt - 2);
            const unsigned k1 = (unsigned)(t + 1) * (unsigned)kstep;
            const unsigned k2 = last ? 0u : (unsigned)(t + 2) * (unsigned)kstep, k3 = k2 + (unsigned)kstep;
            unsigned o2[2][2];
#pragma unroll
            for (int _h = 0; _h < 2; ++_h)
#pragma unroll
                for (int _i = 0; _i < 2; ++_i) o2[_h][_i] = last ? gnA[_h][_i] : goA[_h][_i];
            const char* b2 = last ? nB : cB + (size_t)(t + 2) * kstep;
            const char* b3 = b2 + kstep;
            if constexpr (SP2) {
            PG8_LDB(B0, 0, 0); PG8_LDB(B1, 0, 1); PG8_SCHED; PG8_LDA(At, 0, 0); PG8_STAGEA(PG8_SA(1, 1), k1, goA[1]);
            PG8_WAIT_V(8); PG8_WAIT_L(0); PG8_BAR; PG8_MMA(0, 0, At, B0); PG8_MMA(0, 1, At, B1); PG8_BAR; PG8_SCHED;
            PG8_LDA(At, 0, 1); PG8_STAGE(PG8_SB(0, 0), b2, voffB); PG8_STAGE(PG8_SB(0, 1), b2 + hstep, voffB); PG8_STAGEA(PG8_SA(0, 0), k2, o2[0]);
            PG8_WAIT_V(8); PG8_WAIT_L(0); PG8_BAR; PG8_MMA(1, 0, At, B0); PG8_MMA(1, 1, At, B1); PG8_BAR; PG8_SCHED;
            PG8_LDB(B0, 1, 0); PG8_LDB(B1, 1, 1); PG8_SCHED; PG8_LDA(At, 1, 0); PG8_STAGEA(PG8_SA(0, 1), k2, o2[1]);
            PG8_WAIT_V(8); PG8_WAIT_L(0); PG8_BAR; PG8_MMA(0, 0, At, B0); PG8_MMA(0, 1, At, B1); PG8_BAR; PG8_SCHED;
            PG8_LDA(At, 1, 1); PG8_STAGE(PG8_SB(1, 0), b3, voffB); PG8_STAGE(PG8_SB(1, 1), b3 + hstep, voffB); PG8_STAGEA(PG8_SA(1, 0), k3, o2[0]);
            PG8_WAIT_V(8); PG8_WAIT_L(0); PG8_BAR; PG8_MMA(1, 0, At, B0); PG8_MMA(1, 1, At, B1); PG8_BAR; PG8_SCHED;
            } else {
            static_assert(SP2, "only the SP2 loop is kept");
            }
        }
        if constexpr (ALIGN_EPI) { if (wr == 0) PG8_BAR; }
        E(acc, cur, wr, wc, fr, fq);
        if (!has_next) break;
#pragma unroll
        for (int a = 0; a < 2; ++a)
#pragma unroll
            for (int b = 0; b < 2; ++b)
#pragma unroll
                for (int m = 0; m < 4; ++m)
#pragma unroll
                    for (int n = 0; n < 2; ++n) acc[a][b][m][n] = (f32x4){0.f, 0.f, 0.f, 0.f};
        cur = nxt; cB = nB; ++ui;
        goA[0][0] = gnA[0][0]; goA[0][1] = gnA[0][1]; goA[1][0] = gnA[1][0]; goA[1][1] = gnA[1][1];
        if constexpr (ALIGN_EPI) { if (wr == 1) PG8_BAR; }
    }
    PG8_WAIT_V(0);
    if constexpr (!ALIGN_EPI) { if (wr == 0) PG8_BAR; }
    PG8_BAR;
#undef PG8_SA
#undef PG8_SB
#undef PG8_STAGE
#undef PG8_STAGEA
#undef PG8_ROWS
#undef PG8_LDA
#undef PG8_LDB
#undef PG8_MMA
#undef PG8_WAIT_V
#undef PG8_WAIT_L
#undef PG8_BAR
#undef PG8_SCHED
}
}

constexpr int DM = 2048, NB = 4, SEQ = 4096, CL = 256, RPB = SEQ + CL, MROWS = NB * RPB, MT = MROWS / 256;
constexpr int NE = 64, FF = 512, A_IN = 4608, LCAP = 17408;
constexpr int XS_BLK = 472, SH_BLK = 68;
constexpr float DN_ALPHA = 1.4142135623730951f;
constexpr float LN_EPS = 1e-5f, RMS_EPS = 1e-6f;

constexpr size_t MiB = 1u << 20;
constexpr size_t WS_CTL = 0, CTL_ZERO_BYTES = 1 * MiB;
constexpr size_t WS_MOD = 1 * MiB;
constexpr size_t WS_ROPE128 = 2 * MiB;
constexpr size_t WS_ROPE64 = 4 * MiB;
constexpr size_t WS_TE = 5 * MiB;
constexpr size_t WS_TW = 6 * MiB;
constexpr size_t WS_INV = 7 * MiB;
constexpr size_t WS_W_IN = 8 * MiB;
constexpr size_t WS_W_OUT0 = 26 * MiB;
constexpr size_t WS_W_DOWN = 34 * MiB;
constexpr size_t WS_W_UQKV = 39 * MiB;
constexpr size_t WS_W_OUT1 = 46 * MiB;
constexpr size_t WS_W_RT = 54 * MiB;
constexpr size_t WS_W_GU = 56 * MiB;
constexpr size_t WS_W_D = 576 * MiB;
constexpr size_t WS_X = 836 * MiB;
constexpr size_t WS_UM = 972 * MiB;
constexpr size_t WS_XS = 1040 * MiB;
constexpr size_t WS_U = WS_XS + (size_t)XS_BLK * MiB;
constexpr size_t WS_ULO = WS_U + (size_t)SH_BLK * MiB;
constexpr size_t WS_Y = WS_XS;
constexpr size_t WS_H = 1648 * MiB;
constexpr size_t WS_PROJ = 1783 * MiB;
constexpr size_t WS_Y1_0 = WS_PROJ;
constexpr size_t WS_MIX = 1936 * MiB;
constexpr size_t WS_LOG = 2004 * MiB;
constexpr size_t WS_LIST = 2022 * MiB;
constexpr size_t WS_END = 2027 * MiB;
constexpr size_t WS_DOWNP = 1040 * MiB;
constexpr size_t WS_CQKV = 1083 * MiB;
constexpr size_t WS_KR = 1117 * MiB;
constexpr size_t WS_QB = 1120 * MiB;
constexpr size_t WS_KVB = 1222 * MiB;
constexpr size_t WS_ATT = 1358 * MiB;
constexpr size_t WS_Y1_1 = 1426 * MiB;
static_assert(WS_Y1_1 + 68 * MiB <= WS_U, "layer-1 mixer buffers inside XS");
constexpr size_t W_GU_L = (size_t)65 * 1024 * 2048, W_D_L = (size_t)65 * 2048 * 512;

constexpr int CW_TMO = 0, CW_BAR = 4096, CW_CNT = 8192, CW_NBLK = 8192 + 256;

constexpr int LDS_BYTES = 155648, RING_BYTES = 147456, MISC_OFF = RING_BYTES + 320;
constexpr int MOE_TAB_OFF = 131072;

#define XB_TMO      128
#define XB_XCNT(j)  (256  + 64 * (j))
#define XB_XSUB(j)  (1280 + 64 * (j))
#define XB_XGEN(j)  (2304 + 64 * (j))
#define XB_TOP      3328
#define XB_TOPGEN   3392
#define XCD_BAR_WORDS 3456
#define XB_SPIN_CAP (1u << 18)
__device__ __forceinline__ unsigned xb_ld(unsigned* p)              { return __hip_atomic_load(p, __ATOMIC_RELAXED, __HIP_MEMORY_SCOPE_AGENT); }
__device__ __forceinline__ unsigned xb_add(unsigned* p, unsigned v) { return __hip_atomic_fetch_add(p, v, __ATOMIC_RELAXED, __HIP_MEMORY_SCOPE_AGENT); }
__device__ __forceinline__ unsigned xb_xcc_id() { return (unsigned)__builtin_amdgcn_s_getreg((3 << 11) | 20) & 0xFu; }
#define XB_SPIN(cond, bar) do { unsigned _sp = 0; while (cond) { __builtin_amdgcn_s_sleep(1); \
    if ((++_sp & 255u) == 0u) { if (xb_ld(&(bar)[XB_TMO])) break; if (_sp > XB_SPIN_CAP) { atomicAdd(&(bar)[XB_TMO], 1u); break; } } } } while (0)
struct XcdBarrier { unsigned* bar; unsigned x; volatile LAS unsigned* st; };
__device__ __forceinline__ XcdBarrier xcd_barrier_post(unsigned* bar, volatile LAS unsigned* st) {
    XcdBarrier b; b.bar = bar; b.x = xb_xcc_id(); b.st = st;
    if (threadIdx.x == 0) (void)xb_add(&bar[XB_XCNT(b.x)], 1u);
    return b;
}
__device__ __forceinline__ void xcd_barrier_complete(unsigned* bar, unsigned x, unsigned& nloc, unsigned& nx) {
    const unsigned G = gridDim.x * gridDim.y * gridDim.z;
    unsigned sum, cnt, mine, sp = 0u;
    for (;;) {
        sum = 0u; cnt = 0u; mine = 0u;
#pragma unroll
        for (unsigned j = 0; j < 16; ++j) { const unsigned c = xb_ld(&bar[XB_XCNT(j)]); sum += c; cnt += (c > 0u) ? 1u : 0u; mine = (j == x) ? c : mine; }
        if (sum == G) break;
        __builtin_amdgcn_s_sleep(1);
        if ((++sp & 255u) == 0u) { if (xb_ld(&bar[XB_TMO])) break; if (sp > XB_SPIN_CAP) { atomicAdd(&bar[XB_TMO], 1u); break; } }
    }
    nloc = mine > 0u ? mine : 1u; nx = cnt > 0u ? cnt : 1u;
}
__device__ __forceinline__ void xcd_barrier(const XcdBarrier& b) {
    asm volatile("s_waitcnt vmcnt(0)" ::: "memory");
    __syncthreads();
    if (threadIdx.x == 0) {
        unsigned* bar = b.bar;
        __builtin_amdgcn_s_waitcnt(0);
        unsigned nloc = b.st[0], nx = b.st[1];
        if (nloc == 0u) { xcd_barrier_complete(bar, b.x, nloc, nx); b.st[0] = nloc; b.st[1] = nx; }
        const unsigned old = xb_add(&bar[XB_XSUB(b.x)], 1u);
        const unsigned gen = old / nloc;
        if (old + 1u == (gen + 1u) * nloc) {
            __builtin_amdgcn_fence(__ATOMIC_RELEASE, "agent");
            asm volatile("s_waitcnt vmcnt(0)" ::: "memory");
            const unsigned og = xb_add(&bar[XB_TOP], 1u);
            const unsigned tg = og / nx;
            if (og + 1u == (tg + 1u) * nx) xb_add(&bar[XB_TOPGEN], 1u);
            else XB_SPIN(xb_ld(&bar[XB_TOPGEN]) == tg, bar);
            __builtin_amdgcn_fence(__ATOMIC_ACQUIRE, "agent");
            xb_add(&bar[XB_XGEN(b.x)], 1u);
            asm volatile("s_waitcnt vmcnt(0)" ::: "memory");
        } else {
            XB_SPIN(xb_ld(&bar[XB_XGEN(b.x)]) == gen, bar);
            __builtin_amdgcn_fence(__ATOMIC_ACQUIRE, "agent");
            asm volatile("s_waitcnt vmcnt(0)" ::: "memory");
        }
    }
    __syncthreads();
}

struct Args { const float* in[27]; float* out; unsigned char* ws; int ph_lo, ph_hi; };
enum { I_X = 0, I_C, I_CTX, I_CCTX, I_WADA, I_BADA, I_LNG, I_LNB, I_AWIN, I_ACONV, I_AQG, I_AKG, I_AWOUT, I_MWDOWN, I_MQG, I_MKVG, I_MWUQ, I_MWUKV, I_MWOUT,
       I_RW, I_RB, I_EWG, I_EWU, I_EWD, I_SWG, I_SWU, I_SWD };

struct Ctx {
    LAS unsigned char* lds; int tid, lane, wave, G, bid, vcu, gw, ngw;
    unsigned char* ws; unsigned* ctl;
};
__device__ __forceinline__ void row_info(int r, int& b, int& p) { b = r / RPB; p = r - b * RPB; }
__device__ __forceinline__ const float* in_row(const Args& a, int b, int p) {
    return p < CL ? a.in[I_CTX] + ((size_t)(b * CL + p)) * DM : a.in[I_X] + ((size_t)(b * SEQ + (p - CL))) * DM;
}

template <bool SPLIT>
__device__ __forceinline__ void tr_item(const float* __restrict__ src, int ldw, bf16* dst, bf16* dst_lo, int ldd, LAS float* scr, int lane) {
#pragma unroll 8
    for (int i = 0; i < 32; ++i) { const int kk = 2 * i + (lane >> 5); scr[kk * 33 + (lane & 31)] = src[(size_t)kk * ldw + (lane & 31)]; }
    LDS_WAIT(); asm volatile("" ::: "memory");
    const int c = lane & 7;
#pragma unroll
    for (int j = 0; j < 4; ++j) { const int n = (lane >> 3) + 8 * j; const LAS float* s = scr + (8 * c) * 33 + n;
        float v[8];
#pragma unroll
        for (int q = 0; q < 8; ++q) v[q] = s[q * 33];
        u32x4 o; o.x = cvt_pk_bf16(v[0], v[1]); o.y = cvt_pk_bf16(v[2], v[3]); o.z = cvt_pk_bf16(v[4], v[5]); o.w = cvt_pk_bf16(v[6], v[7]);
        *(u32x4*)(dst + (size_t)n * ldd + 8 * c) = o;
        if constexpr (SPLIT) {
            u32x4 l; l.x = cvt_pk_bf16(v[0] - bf_lo(o.x), v[1] - bf_hi(o.x)); l.y = cvt_pk_bf16(v[2] - bf_lo(o.y), v[3] - bf_hi(o.y));
            l.z = cvt_pk_bf16(v[4] - bf_lo(o.z), v[5] - bf_hi(o.z)); l.w = cvt_pk_bf16(v[6] - bf_lo(o.w), v[7] - bf_hi(o.w));
            *(u32x4*)(dst_lo + (size_t)n * ldd + 8 * c) = l;
        }
    }
    LDS_WAIT(); asm volatile("" ::: "memory");
}

__device__ __forceinline__ void p0_prologue(const Ctx& C, const Args& a) {
    unsigned char* ws = C.ws;
    {
        LAS float* sv = (LAS float*)C.lds;
        LAS float* red = (LAS float*)(C.lds + 40960);
        for (int i = C.tid; i < 5 * DM; i += 512) { const int r = i / DM, k = i - r * DM; const float c = (r < 4) ? a.in[I_C][r * DM + k] : a.in[I_CCTX][k]; sv[i] = c / (1.f + __expf(-c)); }
        __syncthreads();
        float* mod = (float*)(ws + WS_MOD);
        for (int chunk = C.bid; chunk < 256; chunk += C.G) {
            const int l = chunk >> 7, col0 = (chunk & 127) * 96;
            if (C.tid < 384) {
                const int cg = C.tid % 24, ks = C.tid / 24;
                f32x4 acc[5];
#pragma unroll
                for (int r = 0; r < 5; ++r) acc[r] = (f32x4){0.f, 0.f, 0.f, 0.f};
                const float* W = a.in[I_WADA] + ((size_t)l * DM + ks * 128) * 12288 + col0 + 4 * cg;
                const LAS float* s0 = sv + ks * 128;
#pragma unroll 8
                for (int k = 0; k < 128; ++k) { const f32x4 w = *(const f32x4*)(W + (size_t)k * 12288);
#pragma unroll
                    for (int r = 0; r < 5; ++r) { const float s = s0[r * DM + k]; acc[r] += w * s; } }
#pragma unroll
                for (int r = 0; r < 5; ++r) *(LAS f32x4*)(red + (ks * 5 + r) * 96 + 4 * cg) = acc[r];
            }
            __syncthreads();
            if (C.tid < 480) { const int r = C.tid / 96, c = C.tid - r * 96; float s = a.in[I_BADA][l * 12288 + col0 + c];
#pragma unroll
                for (int ks = 0; ks < 16; ++ks) s += red[(ks * 5 + r) * 96 + c];
                mod[((size_t)l * 5 + r) * 12288 + col0 + c] = s; }
            __syncthreads();
        }
    }
    {
        f32x2* r128 = (f32x2*)(ws + WS_ROPE128); f32x2* r64 = (f32x2*)(ws + WS_ROPE64);
        const int gt = C.bid * 512 + C.tid, ngt = C.G * 512;
        for (int i = gt; i < SEQ * 64; i += ngt) { const int s = i >> 6, j = i & 63; const float pos = (float)((j < 32) ? (s >> 6) : (s & 63)); const int f = j & 31;
            const float inv = exp2f(-(float)f * (13.287712379549449f / 32.f)); const float ang = pos * inv; r128[i] = (f32x2){cosf(ang), sinf(ang)}; }
        for (int i = gt; i < SEQ * 32; i += ngt) { const int s = i >> 5, j = i & 31; const float pos = (float)((j < 16) ? (s >> 6) : (s & 63)); const int f = j & 15;
            const float inv = exp2f(-(float)f * (13.287712379549449f / 16.f)); const float ang = pos * inv; r64[i] = (f32x2){cosf(ang), sinf(ang)}; }
        const u32x4 z = {0u, 0u, 0u, 0u};
        u32x4* zd = (u32x4*)(ws + WS_W_DOWN + (size_t)1088 * 4096);
        for (int i = gt; i < 192 * 256; i += ngt) zd[i] = z;
    }
    __syncthreads();
    {
        LAS float* scr = (LAS float*)(C.lds + C.wave * 16384);
        constexpr int J0 = 32 * 144, J1 = 32 * 64, J2 = 32 * 34, J3 = 8 * 96, J4 = 8 * 128, J5 = 32 * 64, J6 = 2 * 32 * 2, J7 = 2 * 64 * 512, J8 = J7, J9 = 2 * 64 * 512, J10 = 2 * 512, J11 = J10, J12 = 2 * 512;
        constexpr int NITEMS = J0 + J1 + J2 + J3 + J4 + J5 + J6 + J7 + J8 + J9 + J10 + J11 + J12;
        bf16* w_in = (bf16*)(ws + WS_W_IN); bf16* w_out0 = (bf16*)(ws + WS_W_OUT0); bf16* w_down = (bf16*)(ws + WS_W_DOWN); bf16* w_uqkv = (bf16*)(ws + WS_W_UQKV);
        bf16* w_out1 = (bf16*)(ws + WS_W_OUT1); bf16* w_rt = (bf16*)(ws + WS_W_RT); bf16* w_gu = (bf16*)(ws + WS_W_GU); bf16* w_d = (bf16*)(ws + WS_W_D);
        for (int it = C.gw; it < NITEMS; it += C.ngw) {
            int r = it;
            if (r < J0) { const int kb = r / 144, nb = r % 144; tr_item<false>(a.in[I_AWIN] + (size_t)kb * 64 * A_IN + nb * 32, A_IN, w_in + (size_t)nb * 32 * DM + kb * 64, nullptr, DM, scr, C.lane); continue; } r -= J0;
            if (r < J1) { const int kb = r / 64, nb = r % 64; tr_item<false>(a.in[I_AWOUT] + (size_t)kb * 64 * DM + nb * 32, DM, w_out0 + (size_t)nb * 32 * DM + kb * 64, nullptr, DM, scr, C.lane); continue; } r -= J1;
            if (r < J2) { const int kb = r / 34, nb = r % 34; tr_item<false>(a.in[I_MWDOWN] + (size_t)kb * 64 * 1088 + nb * 32, 1088, w_down + (size_t)nb * 32 * DM + kb * 64, nullptr, DM, scr, C.lane); continue; } r -= J2;
            if (r < J3) { const int kb = r / 96, nb = r % 96; const int n0 = nb * 32, h = n0 / 192, d = n0 - h * 192;
                const int row = (d < 128) ? (128 * h + d) : (2048 + 256 * (h >> 2) + ((d - 128) ? 128 : 0) + 32 * (h & 3));
                tr_item<false>(a.in[I_MWUQ] + (size_t)kb * 64 * 3072 + n0, 3072, w_uqkv + (size_t)row * 512 + kb * 64, nullptr, 512, scr, C.lane); continue; } r -= J3;
            if (r < J4) { const int kb = r / 128, nb = r % 128; tr_item<false>(a.in[I_MWUKV] + (size_t)kb * 64 * 4096 + nb * 32, 4096, w_uqkv + (size_t)(3072 + nb * 32) * 512 + kb * 64, nullptr, 512, scr, C.lane); continue; } r -= J4;
            if (r < J5) { const int kb = r / 64, nb = r % 64; tr_item<false>(a.in[I_MWOUT] + (size_t)kb * 64 * DM + nb * 32, DM, w_out1 + (size_t)nb * 32 * DM + kb * 64, nullptr, DM, scr, C.lane); continue; } r -= J5;
            if (r < J6) { const int l = r / 64, q = r % 64, kb = q / 2, nb = q % 2; bf16* d = w_rt + (size_t)l * 256 * DM + (size_t)nb * 32 * DM + kb * 64;
                tr_item<true>(a.in[I_RW] + ((size_t)l * DM + kb * 64) * 64 + nb * 32, 64, d, d + (size_t)64 * DM, DM, scr, C.lane); continue; } r -= J6;
            if (r < J7 + J8) { const int up = r >= J7; if (up) r -= J7; const int le = r / 512, q = r % 512, kb = q / 16, nb = q % 16, n0 = nb * 32, l = le >> 6, e = le & 63;
                const float* src = (up ? a.in[I_EWU] : a.in[I_EWG]) + ((size_t)le * DM + kb * 64) * FF + n0;
                bf16* d = w_gu + (size_t)l * W_GU_L + ((size_t)e * 1024 + 256 * (n0 >> 7) + (up ? 128 : 0) + (n0 & 127)) * DM + kb * 64;
                tr_item<false>(src, FF, d, nullptr, DM, scr, C.lane); continue; } r -= J7 + J8;
            if (r < J9) { const int le = r / 512, q = r % 512, kb = q / 64, nb = q % 64, l = le >> 6, e = le & 63;
                tr_item<false>(a.in[I_EWD] + ((size_t)le * FF + kb * 64) * DM + nb * 32, DM, w_d + (size_t)l * W_D_L + ((size_t)e * 2048 + nb * 32) * FF + kb * 64, nullptr, FF, scr, C.lane); continue; } r -= J9;
            if (r < J10 + J11) { const int up = r >= J10; if (up) r -= J10; const int l = r / 512, q = r % 512, kb = q / 16, nb = q % 16, n0 = nb * 32;
                const float* src = (up ? a.in[I_SWU] : a.in[I_SWG]) + ((size_t)l * DM + kb * 64) * FF + n0;
                bf16* d = w_gu + (size_t)l * W_GU_L + ((size_t)NE * 1024 + 256 * (n0 >> 7) + (up ? 128 : 0) + (n0 & 127)) * DM + kb * 64;
                tr_item<false>(src, FF, d, nullptr, DM, scr, C.lane); continue; } r -= J10 + J11;
            { const int l = r / 512, q = r % 512, kb = q / 64, nb = q % 64;
                tr_item<false>(a.in[I_SWD] + ((size_t)l * FF + kb * 64) * DM + nb * 32, DM, w_d + (size_t)l * W_D_L + ((size_t)NE * 2048 + nb * 32) * FF + kb * 64, nullptr, FF, scr, C.lane); }
        }
    }
}

__device__ __forceinline__ void p1_modulate0(const Ctx& C, const Args& a) {
    const float* mod = (const float*)(C.ws + WS_MOD); bf16* um = (bf16*)(C.ws + WS_UM);
    for (int r = C.gw; r < MROWS; r += C.ngw) {
        int b, p; row_info(r, b, p); const float* xr = in_row(a, b, p); const float* mr = mod + (size_t)(p < CL ? 4 : b) * 12288;
#pragma unroll
        for (int j = 0; j < 8; ++j) { const int e = 4 * (C.lane + 64 * j); const f32x4 x = *(const f32x4*)(xr + e), sh = *(const f32x4*)(mr + e), sc = *(const f32x4*)(mr + 2048 + e);
            const f32x4 u = x * (sc + 1.f) + sh; u32x2 w; w.x = cvt_pk_bf16(u[0], u[1]); w.y = cvt_pk_bf16(u[2], u[3]); *(u32x2*)(um + (size_t)r * DM + e) = w; }
    }
}

struct EpiStoreBf16 {
    bf16* O; int ldc;
    __device__ __forceinline__ void operator()(const f32x4 (&acc)[2][2][4][2], const pg8::Unit& u, int wr, int wc, int fr, int fq) const {
        const int row0 = u.pm * 256 + wr * 64 + fr, col0 = u.pn * 256 + wc * 32 + 8 * fq;
#pragma unroll
        for (int ai = 0; ai < 2; ++ai)
#pragma unroll
            for (int m = 0; m < 4; ++m) { bf16* rowp = O + (size_t)(row0 + ai * 128 + m * 16) * ldc + col0;
#pragma unroll
                for (int bj = 0; bj < 2; ++bj) { const f32x4 v0 = acc[ai][bj][m][0], v1 = acc[ai][bj][m][1];
                    u32x4 w; w.x = cvt_pk_bf16(v0[0], v0[1]); w.y = cvt_pk_bf16(v0[2], v0[3]); w.z = cvt_pk_bf16(v1[0], v1[1]); w.w = cvt_pk_bf16(v1[2], v1[3]);
                    *(u32x4*)(rowp + bj * 128) = w; } }
    }
};
struct DenseSched {
    int nM, nN, G, c, lat_only, pm_off, pn_off;
    __device__ __forceinline__ bool next(int i, pg8::Unit& u) const {
        const long L = (long)i * G + c; const int nwg = nM * nN; if (L >= nwg) return false;
        const int w = pg8::xcd_remap((int)L, nwg); int pm, pn; pg8::tile_of(w, nM, nN, pm, pn);
        if (lat_only) pm = 17 * (pm >> 4) + 1 + (pm & 15);
        u.pm = pm + pm_off; u.pn = pn + pn_off; return true;
    }
    __device__ __forceinline__ unsigned rowid(const pg8::Unit& u, int h, int R) const { return (unsigned)(u.pm * 256 + h * 128 + R); }
};

__device__ __forceinline__ void p3_qk_conv(const Ctx& C, const Args& a) {
    bf16* proj = (bf16*)(C.ws + WS_PROJ); bf16* mix = (bf16*)(C.ws + WS_MIX);
    const f32x2* rope = (const f32x2*)(C.ws + WS_ROPE128);
    const float qg0 = a.in[I_AQG][C.lane], qg1 = a.in[I_AQG][C.lane + 64], kg0 = a.in[I_AKG][C.lane], kg1 = a.in[I_AKG][C.lane + 64];
    const float* cw = a.in[I_ACONV];
    for (int r = C.gw; r < MROWS; r += C.ngw) {
        int b, p; row_info(r, b, p); const bool isctx = p < CL;
        bf16* pr = proj + (size_t)r * A_IN;
        f32x2 cs = {1.f, 0.f}; if (!isctx) cs = rope[(size_t)(p - CL) * 64 + C.lane];
#pragma unroll
        for (int h = 0; h < 10; ++h) {
            bf16* hp = pr + 3072 + 128 * h;
            const float x1 = bf2f(hp[C.lane]), x2 = bf2f(hp[C.lane + 64]);
            const float ss = wave_sum(x1 * x1 + x2 * x2);
            const float rs = 1.f / sqrtf(ss * (1.f / 128.f) + RMS_EPS);
            const float y1 = x1 * rs * (h < 8 ? qg0 : kg0), y2 = x2 * rs * (h < 8 ? qg1 : kg1);
            hp[C.lane] = (bf16)f2bf(y1 * cs.x - y2 * cs.y); hp[C.lane + 64] = (bf16)f2bf(y2 * cs.x + y1 * cs.y);
        }
        const int pos = isctx ? p : p - CL, len = isctx ? CL : SEQ;
        const bool hasm = pos > 0, hasp = pos + 1 < len;
#pragma unroll
        for (int j = 0; j < 2; ++j) {
            const int c0 = 8 * (C.lane + 64 * j);
            const u32x4 gb = *(const u32x4*)(pr + c0), gc = *(const u32x4*)(pr + 1024 + c0), hv = *(const u32x4*)(pr + 2048 + c0);
            u32x4 gcm = {0u, 0u, 0u, 0u}, hvm = gcm, gcp = gcm, hvp = gcm;
            if (hasm) { gcm = *(const u32x4*)(pr - A_IN + 1024 + c0); hvm = *(const u32x4*)(pr - A_IN + 2048 + c0); }
            if (hasp) { gcp = *(const u32x4*)(pr + A_IN + 1024 + c0); hvp = *(const u32x4*)(pr + A_IN + 2048 + c0); }
            const f32x4 w0a = *(const f32x4*)(cw + c0), w0b = *(const f32x4*)(cw + c0 + 4), w1a = *(const f32x4*)(cw + 1024 + c0), w1b = *(const f32x4*)(cw + 1024 + c0 + 4),
                        w2a = *(const f32x4*)(cw + 2048 + c0), w2b = *(const f32x4*)(cw + 2048 + c0 + 4);
            float o[8];
#pragma unroll
            for (int q = 0; q < 4; ++q) {
                const float w0l = q < 2 ? w0a[2 * q] : w0b[2 * q - 4], w0h = q < 2 ? w0a[2 * q + 1] : w0b[2 * q - 3];
                const float w1l = q < 2 ? w1a[2 * q] : w1b[2 * q - 4], w1h = q < 2 ? w1a[2 * q + 1] : w1b[2 * q - 3];
                const float w2l = q < 2 ? w2a[2 * q] : w2b[2 * q - 4], w2h = q < 2 ? w2a[2 * q + 1] : w2b[2 * q - 3];
                const float zl = bf_lo(gc[q]) * bf_lo(hv[q]), zh = bf_hi(gc[q]) * bf_hi(hv[q]);
                const float zml = bf_lo(gcm[q]) * bf_lo(hvm[q]), zmh = bf_hi(gcm[q]) * bf_hi(hvm[q]);
                const float zpl = bf_lo(gcp[q]) * bf_lo(hvp[q]), zph = bf_hi(gcp[q]) * bf_hi(hvp[q]);
                o[2 * q] = bf_lo(gb[q]) * (w0l * zml + w1l * zl + w2l * zpl);
                o[2 * q + 1] = bf_hi(gb[q]) * (w0h * zmh + w1h * zh + w2h * zph);
            }
            u32x4 w; w.x = cvt_pk_bf16(o[0], o[1]); w.y = cvt_pk_bf16(o[2], o[3]); w.z = cvt_pk_bf16(o[4], o[5]); w.w = cvt_pk_bf16(o[6], o[7]);
            *(u32x4*)(mix + (size_t)r * DM + c0) = w;
        }
    }
}

namespace att {
constexpr int NW = 8, QBLK = 32, KVBLK = 64;
constexpr int SHM_V = KVBLK * 128 * 2, SHM_K = KVBLK * 128 * 2, SHM_KR = KVBLK * 64 * 2;
constexpr int OFF_V = 0, OFF_K = 2 * SHM_V, OFF_KR = 2 * SHM_V + 2 * SHM_K, OFF_QR = OFF_KR + 2 * SHM_KR, LDS_ATT = OFF_QR + NW * 8192;
constexpr float THR = 8.f;
#define KSWZ(row, colB) ((row) * 256 + ((colB) ^ (((row) & 7) << 4)))
#define KRSWZ(row, colB) ((row) * 128 + ((colB) ^ (((row) & 7) << 4)))
__device__ __forceinline__ bf16x8 ld8(const bf16* p) { return *reinterpret_cast<const bf16x8*>(p); }

__device__ __forceinline__ void partialSM(f32x16& p0, f32x16& p1, float& m_reg, float& mn, float& alpha, const float SCALE) {
    const float Cc = SCALE * 1.4426950408889634f;
    float pmax = p0[0];
#pragma unroll
    for (int r = 1; r < 16; ++r) pmax = fmaxf(pmax, p0[r]);
#pragma unroll
    for (int r = 0; r < 16; ++r) pmax = fmaxf(pmax, p1[r]);
    { auto rr = __builtin_amdgcn_permlane32_swap(__float_as_uint(pmax), __float_as_uint(pmax), false, false);
      pmax = fmaxf(__uint_as_float(rr[0]), __uint_as_float(rr[1])); }
    if (__builtin_expect(__all(pmax - m_reg <= THR / SCALE), 1)) { mn = m_reg; alpha = 1.f; }
    else { mn = fmaxf(m_reg, pmax); alpha = __builtin_amdgcn_exp2f((m_reg - mn) * Cc); m_reg = mn; }
    const float mnC = -mn * Cc;
#pragma unroll
    for (int r = 0; r < 16; ++r) p0[r] = fmaf(p0[r], Cc, mnC);
#pragma unroll
    for (int r = 0; r < 16; ++r) p1[r] = fmaf(p1[r], Cc, mnC);
#pragma unroll
    for (int r = 0; r < 16; ++r) p0[r] = __builtin_amdgcn_exp2f(p0[r]);
}
__device__ __forceinline__ void finishSM(f32x16& p0, f32x16& p1, float alpha, float& l_reg, bf16x8& pa0, bf16x8& pa1, bf16x8& pa2, bf16x8& pa3) {
#pragma unroll
    for (int r = 0; r < 16; ++r) p1[r] = __builtin_amdgcn_exp2f(p1[r]);
    float ps = 0;
#pragma unroll
    for (int r = 0; r < 16; ++r) ps += p0[r];
#pragma unroll
    for (int r = 0; r < 16; ++r) ps += p1[r];
    { auto rr = __builtin_amdgcn_permlane32_swap(__float_as_uint(ps), __float_as_uint(ps), false, false);
      ps = __uint_as_float(rr[0]) + __uint_as_float(rr[1]); }
    l_reg = l_reg * alpha + ps;
#define PK4(P, BASE, OUT) do { unsigned a0 = cvt_pk_bf16(P[BASE + 0], P[BASE + 1]), a1 = cvt_pk_bf16(P[BASE + 2], P[BASE + 3]);   \
    unsigned b0 = cvt_pk_bf16(P[BASE + 4], P[BASE + 5]), b1 = cvt_pk_bf16(P[BASE + 6], P[BASE + 7]);                              \
    auto r0 = __builtin_amdgcn_permlane32_swap(a0, b0, false, false); auto r1 = __builtin_amdgcn_permlane32_swap(a1, b1, false, false); \
    u32x4 w = {r0[0], r1[0], r0[1], r1[1]}; OUT = *reinterpret_cast<bf16x8*>(&w); } while (0)
    PK4(p0, 0, pa0); PK4(p0, 8, pa1); PK4(p1, 0, pa2); PK4(p1, 8, pa3);
#undef PK4
}
#ifndef MLA_SD
#define MLA_SD 1
#endif
#ifndef MLA_NQL
#define MLA_NQL 4
#endif
template <int MLA>
__device__ __forceinline__ void qkt(f32x16& p0, f32x16& p1, const char* Ks, const char* Krs, const bf16x8* qr, const char* qrl, int r32, int hi) {
    constexpr int NQL = MLA ? MLA_NQL : 0;
    p0 = f32x16{}; p1 = f32x16{};
#pragma unroll
    for (int d0 = 0; d0 < 8; ++d0) { const int cb = (d0 * 16 + hi * 8) * 2;
        const bf16x8 b0 = *reinterpret_cast<const bf16x8*>(Ks + KSWZ(r32, cb));
        const bf16x8 b1 = *reinterpret_cast<const bf16x8*>(Ks + KSWZ(32 + r32, cb));
        bf16x8 qf; if (d0 < NQL) qf = *reinterpret_cast<const bf16x8*>(qrl + (4 + d0) * 1024); else qf = qr[d0 - NQL];
        p0 = __builtin_amdgcn_mfma_f32_32x32x16_bf16(b0, qf, p0, 0, 0, 0);
        p1 = __builtin_amdgcn_mfma_f32_32x32x16_bf16(b1, qf, p1, 0, 0, 0); }
    if constexpr (MLA) {
#pragma unroll
        for (int d0 = 0; d0 < 4; ++d0) { const int cb = (d0 * 16 + hi * 8) * 2;
            const bf16x8 b0 = *reinterpret_cast<const bf16x8*>(Krs + KRSWZ(r32, cb));
            const bf16x8 b1 = *reinterpret_cast<const bf16x8*>(Krs + KRSWZ(32 + r32, cb));
            const bf16x8 qf = *reinterpret_cast<const bf16x8*>(qrl + d0 * 1024);
            p0 = __builtin_amdgcn_mfma_f32_32x32x16_bf16(b0, qf, p0, 0, 0, 0);
            p1 = __builtin_amdgcn_mfma_f32_32x32x16_bf16(b1, qf, p1, 0, 0, 0); }
    }
}
__device__ __forceinline__ int v_st(int k, int c) { const int kk = (k & ~0xC) | ((k & 4) << 1) | ((k & 8) >> 1); return ((kk >> 3) * 4 + (c >> 5)) * 512 + ((kk & 7) * 32 + (c & 31)) * 2; }
__device__ __forceinline__ int v_rd_base(int lane) { return ((lane & 3) << 3) | (((lane >> 2) & 3) << 6) | (((lane >> 4) & 1) << 5) | (((lane >> 5) & 1) << 8); }
constexpr int v_rd_off(int d0, int ks, int half) { return d0 * 512 + ks * 4096 + half * 2048; }
template <int OFF> __device__ __forceinline__ s16x4 tr_read(int vb) {
    s16x4 r; asm volatile("ds_read_b64_tr_b16 %0, %1 offset:%2" : "=&v"(r) : "v"(vb), "i"(OFF) : "memory"); return r;
}
template <int D0> __device__ __forceinline__ void pv_one(f32x16& od, int vb, bf16x8 pa0, bf16x8 pa1, bf16x8 pa2, bf16x8 pa3) {
    const s16x4 l0 = tr_read<v_rd_off(D0, 0, 0)>(vb), h0 = tr_read<v_rd_off(D0, 0, 1)>(vb), l1 = tr_read<v_rd_off(D0, 1, 0)>(vb), h1 = tr_read<v_rd_off(D0, 1, 1)>(vb);
    const s16x4 l2 = tr_read<v_rd_off(D0, 2, 0)>(vb), h2 = tr_read<v_rd_off(D0, 2, 1)>(vb), l3 = tr_read<v_rd_off(D0, 3, 0)>(vb), h3 = tr_read<v_rd_off(D0, 3, 1)>(vb);
    asm volatile("s_waitcnt lgkmcnt(0)" ::: "memory"); SBAR();
#define PKV(L, H) (bf16x8){L[0], L[1], L[2], L[3], H[0], H[1], H[2], H[3]}
    od = __builtin_amdgcn_mfma_f32_32x32x16_bf16(PKV(l0, h0), pa0, od, 0, 0, 0);
    od = __builtin_amdgcn_mfma_f32_32x32x16_bf16(PKV(l1, h1), pa1, od, 0, 0, 0);
    od = __builtin_amdgcn_mfma_f32_32x32x16_bf16(PKV(l2, h2), pa2, od, 0, 0, 0);
    od = __builtin_amdgcn_mfma_f32_32x32x16_bf16(PKV(l3, h3), pa3, od, 0, 0, 0);
#undef PKV
}
__device__ __forceinline__ void pv_d0(f32x16* o, int vb, bf16x8 pa0, bf16x8 pa1, bf16x8 pa2, bf16x8 pa3) {
    pv_one<0>(o[0], vb, pa0, pa1, pa2, pa3); pv_one<1>(o[1], vb, pa0, pa1, pa2, pa3); pv_one<2>(o[2], vb, pa0, pa1, pa2, pa3); pv_one<3>(o[3], vb, pa0, pa1, pa2, pa3);
}

template <int MLA>
__device__ __forceinline__ void attn_unit(const bf16* __restrict__ Qn, const bf16* __restrict__ Qr, int ldq, const bf16* __restrict__ Kn, const bf16* __restrict__ Vn, int ldk,
                                          const bf16* __restrict__ Kr, bf16* __restrict__ O, int ldo, int seq, const float SCALE, char* lds) {
    constexpr int NQL = MLA ? MLA_NQL : 0, SD = MLA ? MLA_SD : 2;
    const int tid = threadIdx.x, wid = tid >> 6, lane = tid & 63, r32 = lane & 31, hi = lane >> 5;
    char* V_lds = lds + OFF_V; char* K_lds = lds + OFF_K; char* KR_lds = lds + OFF_KR;
    float m_reg = -1e30f, l_reg = 0; f32x16 o[4] = {}; bf16x8 qr[NQL < 8 ? 8 - NQL : 1];
    char* qrl = lds + OFF_QR + wid * 8192 + lane * 16;
    const bf16* Qw = Qn + (long)(wid * QBLK + r32) * ldq + hi * 8;
#pragma unroll
    for (int d0 = 0; d0 < 8; ++d0) { if (d0 < NQL) *(bf16x8*)(qrl + (4 + d0) * 1024) = ld8(Qw + d0 * 16); else qr[d0 - NQL] = ld8(Qw + d0 * 16); }
    if constexpr (MLA) { const bf16* Qx = Qr + (long)(wid * QBLK + r32) * ldq + hi * 8;
        *(bf16x8*)(qrl) = ld8(Qx); *(bf16x8*)(qrl + 1024) = ld8(Qx + 16); *(bf16x8*)(qrl + 2048) = ld8(Qx + 128); *(bf16x8*)(qrl + 3072) = ld8(Qx + 144); }
    const int sr = tid >> 4, sc = (tid & 15) * 8, vst0 = v_st(sr, sc), vst1 = v_st(32 + sr, sc);
    const int krr = tid >> 3, krc = (tid & 7) * 8;
    const int vb0 = (int)(uintptr_t)V_lds + v_rd_base(lane);
    struct { bf16x8 vs0, vs1, ks0, ks1, kr; } sr_[SD];
#define SLOAD(i, k0) do { sr_[i].vs0 = ld8(&Vn[(long)((k0) + sr) * ldk + sc]); sr_[i].vs1 = ld8(&Vn[(long)((k0) + 32 + sr) * ldk + sc]); \
    sr_[i].ks0 = ld8(&Kn[(long)((k0) + sr) * ldk + sc]); sr_[i].ks1 = ld8(&Kn[(long)((k0) + 32 + sr) * ldk + sc]); \
    if constexpr (MLA) sr_[i].kr = ld8(&Kr[(long)((k0) + krr) * 64 + krc]); } while (0)
#define SWRITE(b, i) do { *(bf16x8*)(V_lds + (b) * SHM_V + vst0) = sr_[i].vs0; *(bf16x8*)(V_lds + (b) * SHM_V + vst1) = sr_[i].vs1; { const int kc = sc * 2; \
    *(bf16x8*)(K_lds + (b) * SHM_K + KSWZ(sr, kc)) = sr_[i].ks0; *(bf16x8*)(K_lds + (b) * SHM_K + KSWZ(32 + sr, kc)) = sr_[i].ks1; } \
    if constexpr (MLA) *(bf16x8*)(KR_lds + (b) * SHM_KR + KRSWZ(krr, krc * 2)) = sr_[i].kr; } while (0)
#define SWAIT() do { if constexpr (SD == 1) asm volatile("s_waitcnt vmcnt(0)" ::: "memory"); else if constexpr (MLA) asm volatile("s_waitcnt vmcnt(5)" ::: "memory"); else asm volatile("s_waitcnt vmcnt(4)" ::: "memory"); } while (0)
#define RESC(a) do { if (__any((a) < 1.f)) { _Pragma("unroll") for (int d = 0; d < 4; ++d) _Pragma("unroll") for (int r = 0; r < 16; ++r) o[d][r] *= (a); } } while (0)
    f32x16 pA0, pA1, pB0, pB1; float mnA, mnB, alA, alB; bf16x8 pa0, pa1, pa2, pa3; const int NT = seq / KVBLK;
    constexpr int SE = 0, SO = SD - 1;
    SLOAD(SE, 0); asm volatile("s_waitcnt vmcnt(0)" ::: "memory"); SWRITE(0, SE); __syncthreads();
    qkt<MLA>(pA0, pA1, K_lds, KR_lds, qr, qrl, r32, hi); partialSM(pA0, pA1, m_reg, mnA, alA, SCALE);
    SLOAD(SO, KVBLK); if constexpr (SD == 2) { if (2 < NT) SLOAD(SE, 2 * KVBLK); }
    SWAIT(); SWRITE(1, SO); __syncthreads();
    for (int j = 1; j + 1 < NT; j += 2) {
        SBAR(); qkt<MLA>(pB0, pB1, K_lds + SHM_K, KR_lds + SHM_KR, qr, qrl, r32, hi);
        finishSM(pA0, pA1, alA, l_reg, pa0, pa1, pa2, pa3); SBAR();
        SLOAD(SO, (j + SD) * KVBLK); SBAR();
        pv_d0(o, vb0, pa0, pa1, pa2, pa3); partialSM(pB0, pB1, m_reg, mnB, alB, SCALE);
        __syncthreads(); SWAIT(); SWRITE(0, SE);
        RESC(alB); __syncthreads();
        SBAR(); qkt<MLA>(pA0, pA1, K_lds, KR_lds, qr, qrl, r32, hi);
        finishSM(pB0, pB1, alB, l_reg, pa0, pa1, pa2, pa3); SBAR();
        if (SD == 1 || j + 3 < NT) SLOAD(SE, (j + 1 + SD) * KVBLK); SBAR();
        pv_d0(o, vb0 + SHM_V, pa0, pa1, pa2, pa3); partialSM(pA0, pA1, m_reg, mnA, alA, SCALE);
        __syncthreads(); SWAIT(); SWRITE(1, SO);
        RESC(alA); __syncthreads();
    }
    SBAR(); qkt<MLA>(pB0, pB1, K_lds + SHM_K, KR_lds + SHM_KR, qr, qrl, r32, hi);
    finishSM(pA0, pA1, alA, l_reg, pa0, pa1, pa2, pa3); SBAR();
    pv_d0(o, vb0, pa0, pa1, pa2, pa3); partialSM(pB0, pB1, m_reg, mnB, alB, SCALE);
    __syncthreads(); RESC(alB);
    finishSM(pB0, pB1, alB, l_reg, pa0, pa1, pa2, pa3); SBAR();
    pv_d0(o, vb0 + SHM_V, pa0, pa1, pa2, pa3);
    const float rl = __builtin_amdgcn_rcpf(l_reg);
    bf16* Ow = O + (long)(wid * QBLK + r32) * ldo + 4 * hi;
#pragma unroll
    for (int d0 = 0; d0 < 4; ++d0)
#pragma unroll
        for (int g = 0; g < 4; ++g) { u32x2 w; w.x = cvt_pk_bf16(o[d0][4 * g] * rl, o[d0][4 * g + 1] * rl); w.y = cvt_pk_bf16(o[d0][4 * g + 2] * rl, o[d0][4 * g + 3] * rl);
            *(u32x2*)(Ow + 32 * d0 + 8 * g) = w; }
    __syncthreads();
#undef SLOAD
#undef SWRITE
#undef SWAIT
#undef RESC
}
}
static_assert(att::LDS_ATT <= RING_BYTES, "attention LDS");

__device__ __forceinline__ void p4_attn0(const Ctx& C) {
    const bf16* proj = (const bf16*)(C.ws + WS_PROJ); bf16* mix = (bf16*)(C.ws + WS_MIX);
    const float scale = 0.08838834764831845f;
    for (int u = C.vcu; u < 512 + 32; u += C.G) {
        int b, h, row0, seq;
        if (u < 512) { const int pair = u >> 6, w = u & 63; b = pair >> 1; h = (pair & 1) * 4 + (w >> 4); row0 = b * RPB + CL + 256 * (w & 15); seq = RPB; }
        else { const int v = u - 512; b = v >> 3; h = v & 7; row0 = b * RPB; seq = CL; }
        const int kvh = h >> 2; const bf16* kb = proj + (size_t)b * RPB * A_IN;
        att::attn_unit<0>(proj + (size_t)row0 * A_IN + 3072 + 128 * h, nullptr, A_IN, kb + 4096 + 128 * kvh, kb + 4352 + 128 * kvh, A_IN, nullptr,
                          mix + (size_t)row0 * DM + 1024 + 128 * h, DM, seq, scale, (char*)C.lds);
    }
}

template <int L>
__device__ __forceinline__ void p_ln_route(const Ctx& C, const Args& a) {
    constexpr int NQ = (L == 0) ? MROWS : NB * SEQ, PITCH = 4112;
    const float* mod = (const float*)(C.ws + WS_MOD) + (size_t)L * 5 * 12288; float* X = (float*)(C.ws + WS_X);
    const bf16* y1 = (const bf16*)(C.ws + (L == 0 ? WS_Y1_0 : WS_Y1_1)); bf16* U = (bf16*)(C.ws + WS_U);
    const float* lng = a.in[I_LNG] + (size_t)(L * 2 + 0) * DM; const float* lnb = a.in[I_LNB] + (size_t)(L * 2 + 0) * DM;
    int* TE = (int*)(C.ws + WS_TE); float* TW = (float*)(C.ws + WS_TW); int* INV = (int*)(C.ws + WS_INV); int* LIST = (int*)(C.ws + WS_LIST);
    const bf16* wrt = (const bf16*)(C.ws + WS_W_RT) + (size_t)L * 256 * DM;
    LAS unsigned char* AH = C.lds; LAS unsigned char* AL = C.lds + 16 * PITCH; LAS float* PART = (LAS float*)C.lds;
    LAS int* hist = (LAS int*)(C.lds + 2 * 16 * PITCH); LAS int* base = hist + 64; LAS int* rec = hist + 128;
    if (C.tid < 128) hist[C.tid] = 0;
    __syncthreads();
    const float rb = a.in[I_RB][L * NE + C.lane];
    const float NINF = -__builtin_inff();
    const int per = 16 * C.G, nfull = NQ / per, rem = NQ - nfull * per, nrem = (rem + C.G - 1) / C.G, niter = nfull + (rem ? 1 : 0);
    const int l15 = C.lane & 15, lq = C.lane >> 4;
    f32x4 xr[2][8]; u32x2 yr[2][8];
#define LNR_ROW(itx, jjx, rvar, validvar) const int _nr##jjx = (itx) < nfull ? 16 : nrem; const int _j##jjx = C.wave + 8 * (jjx); const int _q##jjx = (itx) * per + C.bid * _nr##jjx + _j##jjx; \
        const bool validvar = (itx) < niter && _j##jjx < _nr##jjx && _q##jjx < NQ; const int rvar = validvar ? ((L == 0) ? _q##jjx : RPB * (_q##jjx >> 12) + CL + (_q##jjx & 4095)) : 0;
#define LNR_FETCH(itx) do { { LNR_ROW(itx, 0, r0_, v0_) if (v0_) { int b_, p_; row_info(r0_, b_, p_); const float* xo_ = (L == 0) ? in_row(a, b_, p_) : X + (size_t)r0_ * DM; \
            _Pragma("unroll") for (int jx = 0; jx < 8; ++jx) { const int e = 4 * (C.lane + 64 * jx); xr[0][jx] = *(const f32x4*)(xo_ + e); yr[0][jx] = *(const u32x2*)(y1 + (size_t)r0_ * DM + e); } } } \
        { LNR_ROW(itx, 1, r1_, v1_) if (v1_) { int b_, p_; row_info(r1_, b_, p_); const float* xo_ = (L == 0) ? in_row(a, b_, p_) : X + (size_t)r1_ * DM; \
            _Pragma("unroll") for (int jx = 0; jx < 8; ++jx) { const int e = 4 * (C.lane + 64 * jx); xr[1][jx] = *(const f32x4*)(xo_ + e); yr[1][jx] = *(const u32x2*)(y1 + (size_t)r1_ * DM + e); } } } } while (0)
    LNR_FETCH(0);
    for (int it = 0; it < niter; ++it) {
        const int nrows = it < nfull ? 16 : nrem, q0 = it * per + C.bid * nrows;
#pragma unroll
        for (int jj = 0; jj < 2; ++jj) {
            const int j = C.wave + 8 * jj, q = q0 + j;
            if (j < nrows && q < NQ) {
            const int r = (L == 0) ? q : RPB * (q >> 12) + CL + (q & 4095);
            int b, p; row_info(r, b, p); const bool isctx = p < CL;
            const float* mr = mod + (size_t)(isctx ? 4 : b) * 12288;
            int ln = C.lane; asm volatile("" : "+v"(ln));
            f32x4 t[8]; float s = 0.f;
#pragma unroll
            for (int jx = 0; jx < 8; ++jx) { const int e = 4 * (ln + 64 * jx); const f32x4 x = xr[jj][jx], g = *(const f32x4*)(mr + 4096 + e); const u32x2 yw = yr[jj][jx];
                const f32x4 y = {bf_lo(yw.x), bf_hi(yw.x), bf_lo(yw.y), bf_hi(yw.y)}; t[jx] = x * DN_ALPHA + g * y; s += (t[jx][0] + t[jx][1]) + (t[jx][2] + t[jx][3]); if (jx == 3) SBAR(); }
            const float mean = wave_sum(s) * (1.f / DM); float s2 = 0.f;
#pragma unroll
            for (int jx = 0; jx < 8; ++jx) { t[jx] = t[jx] - mean; s2 += (t[jx][0] * t[jx][0] + t[jx][1] * t[jx][1]) + (t[jx][2] * t[jx][2] + t[jx][3] * t[jx][3]); }
            const float rstd = 1.f / sqrtf(wave_sum(s2) * (1.f / DM) + LN_EPS);
            SBAR();
#pragma unroll
            for (int jx = 0; jx < 8; ++jx) { const int e = 4 * (ln + 64 * jx); const f32x4 xn = t[jx] * rstd * *(const f32x4*)(lng + e) + *(const f32x4*)(lnb + e);
                *(f32x4*)(X + (size_t)r * DM + e) = xn;
                const f32x4 v = xn * (*(const f32x4*)(mr + 8192 + e) + 1.f) + *(const f32x4*)(mr + 6144 + e);
                u32x2 w; w.x = cvt_pk_bf16(v[0], v[1]); w.y = cvt_pk_bf16(v[2], v[3]); *(u32x2*)(U + (size_t)r * DM + e) = w;
                u32x2 lo; lo.x = cvt_pk_bf16(v[0] - bf_lo(w.x), v[1] - bf_hi(w.x)); lo.y = cvt_pk_bf16(v[2] - bf_lo(w.y), v[3] - bf_hi(w.y));
                *(LAS u32x2*)(AH + j * PITCH + e * 2) = w; *(LAS u32x2*)(AL + j * PITCH + e * 2) = lo;
                if (jx & 1) SBAR(); }
            }
            SBAR();
        }
        SBAR();
        LNR_FETCH(it + 1);
        SBAR();
        __syncthreads();
        f32x4 acc[4];
#pragma unroll
        for (int nt = 0; nt < 4; ++nt) acc[nt] = (f32x4){0.f, 0.f, 0.f, 0.f};
        {
            int lm = C.lane; asm volatile("" : "+v"(lm));
            const int m15 = lm & 15, mq = lm >> 4;
            const LAS unsigned char* ah = AH + m15 * PITCH + (256 * C.wave + 8 * mq) * 2;
            const bf16* bp = wrt + (size_t)m15 * DM + 256 * C.wave + 8 * mq;
#pragma unroll 2
            for (int ks = 0; ks < 8; ++ks) {
                const bf16x8 a_hi = *(const LAS bf16x8*)(ah + ks * 64), a_lo = *(const LAS bf16x8*)(ah + 16 * PITCH + ks * 64);
#pragma unroll
                for (int nt = 0; nt < 4; ++nt) { const bf16x8 b_hi = *(const bf16x8*)(bp + (size_t)(16 * nt) * DM + 32 * ks), b_lo = *(const bf16x8*)(bp + (size_t)(64 + 16 * nt) * DM + 32 * ks);
                    acc[nt] = __builtin_amdgcn_mfma_f32_16x16x32_bf16(a_hi, b_hi, acc[nt], 0, 0, 0);
                    acc[nt] = __builtin_amdgcn_mfma_f32_16x16x32_bf16(a_hi, b_lo, acc[nt], 0, 0, 0);
                    acc[nt] = __builtin_amdgcn_mfma_f32_16x16x32_bf16(a_lo, b_hi, acc[nt], 0, 0, 0); }
            }
        }
        __syncthreads();
#pragma unroll
        for (int nt = 0; nt < 4; ++nt)
#pragma unroll
            for (int rg = 0; rg < 4; ++rg) PART[C.wave * 1024 + (4 * lq + rg) * 64 + 16 * nt + l15] = acc[nt][rg];
        __syncthreads();
#pragma unroll 1
        for (int jj = 0; jj < 2; ++jj) {
            const int j = C.wave + 8 * jj, q = q0 + j; if (j >= nrows || q >= NQ) continue;
            const int r = (L == 0) ? q : RPB * (q >> 12) + CL + (q & 4095);
            int lr_ = C.lane; asm volatile("" : "+v"(lr_));
            float lg = 0.f;
#pragma unroll
            for (int w = 0; w < 8; ++w) lg += PART[w * 1024 + j * 64 + C.lane];
            const float sc = 1.f / (1.f + __expf(-lg));
            const float sel = sc + rb;
            float m1 = sel; m1 = fmaxf(m1, __shfl_xor(m1, 1)); m1 = fmaxf(m1, __shfl_xor(m1, 2)); m1 = fmaxf(m1, __shfl_xor(m1, 4));
            const unsigned long long eq = __ballot(sel == m1); const int g = lr_ >> 3;
            const unsigned gm = (unsigned)(eq >> (8 * g)) & 0xFFu; const int first = 8 * g + (__ffs(gm) - 1);
            float m2 = (lr_ == first) ? NINF : sel; m2 = fmaxf(m2, __shfl_xor(m2, 1)); m2 = fmaxf(m2, __shfl_xor(m2, 2)); m2 = fmaxf(m2, __shfl_xor(m2, 4));
            const float gs = m1 + m2;
            int grank = 0;
#pragma unroll
            for (int qq = 0; qq < 8; ++qq) { const float o = __int_as_float(__builtin_amdgcn_readlane(__float_as_int(gs), 8 * qq)); grank += (o > gs || (o == gs && qq < g)) ? 1 : 0; }
            const bool gsel = grank < 4;
            const float ms = gsel ? sel : NINF;
            int rank = 0;
#pragma unroll
            for (int qq = 0; qq < 64; ++qq) { const float o = __int_as_float(__builtin_amdgcn_readlane(__float_as_int(ms), qq)); rank += (o > ms || (o == ms && qq < lr_)) ? 1 : 0; }
            const bool chosen = gsel && rank < 6;
            const float wsum = wave_sum(chosen ? sc : 0.f);
            if (chosen) {
                const int lr = atomicAdd((int*)&hist[C.lane], 1);
                rec[((it * 16 + j) * 8 + rank) * 2] = C.lane; rec[((it * 16 + j) * 8 + rank) * 2 + 1] = lr;
                TW[(size_t)r * 8 + rank] = sc / wsum * 2.5f;
            }
        }
        __syncthreads();
    }
#undef LNR_FETCH
#undef LNR_ROW
    if (C.tid < 64) { const int h = hist[C.tid]; base[C.tid] = h ? (int)__hip_atomic_fetch_add(C.ctl + CW_CNT + L * 64 + C.tid, (unsigned)h, RLX_AGENT) : 0; }
    __syncthreads();
    for (int it = 0; it < niter; ++it) {
        const int nrows = it < nfull ? 16 : nrem, q0 = it * per + C.bid * nrows;
#pragma unroll 1
        for (int jj = 0; jj < 2; ++jj) {
            const int j = C.wave + 8 * jj, q = q0 + j; if (j >= nrows || q >= NQ) continue;
            const int r = (L == 0) ? q : RPB * (q >> 12) + CL + (q & 4095);
            if (C.lane < 6) { const int e = rec[((it * 16 + j) * 8 + C.lane) * 2], gr = rec[((it * 16 + j) * 8 + C.lane) * 2 + 1] + base[e];
                TE[(size_t)r * 8 + C.lane] = e; INV[(size_t)r * 8 + C.lane] = gr; LIST[(size_t)e * LCAP + gr] = r; }
        }
    }
    __syncthreads();
}

struct MoeTab { LAS int* cnt; LAS int* bstart; LAS int* blke; };
template <int L>
__device__ __forceinline__ MoeTab moe_tables(const Ctx& C) {
    MoeTab T; T.cnt = (LAS int*)(C.lds + MOE_TAB_OFF); T.bstart = T.cnt + 64; T.blke = T.cnt + 192;
    __syncthreads();
    if (C.tid < 64) T.cnt[C.tid] = (int)__hip_atomic_load(C.ctl + CW_CNT + L * 64 + C.tid, RLX_AGENT);
    __syncthreads();
    if (C.tid == 0) { int acc = 0; for (int e = 0; e < NE; ++e) { T.bstart[e] = acc; const int nb = (T.cnt[e] + 255) >> 8; for (int q = 0; q < nb && acc + q < XS_BLK; ++q) T.blke[acc + q] = e; acc += nb; if (acc > XS_BLK) acc = XS_BLK; }
        T.bstart[NE] = acc; }
    __syncthreads();
    return T;
}
struct MoeSched {
    MoeTab T; const int* list; int nblk_r, nsh, ncol, G, c, sh_lat_only, gather;
    __device__ __forceinline__ bool next(int i, pg8::Unit& u) const {
        const int total = (nblk_r + nsh) * ncol; const long Lq = (long)i * G + c; if (Lq >= total) return false;
        const int w = pg8::xcd_remap((int)Lq, total); const int b = w / ncol, j = w - b * ncol;
        int e, pm;
        if (b < nblk_r) { pm = b; e = T.blke[b]; } else { int sb = b - nblk_r; if (sh_lat_only) sb = 17 * (sb >> 4) + 1 + (sb & 15); pm = XS_BLK + sb; e = NE; }
        u.pm = pm; u.pn = e * ncol + j; return true;
    }
    __device__ __forceinline__ unsigned rowid(const pg8::Unit& u, int h, int R) const {
        if (!gather) return (unsigned)(u.pm * 256 + h * 128 + R);
        if (u.pm >= XS_BLK) return (unsigned)((u.pm - XS_BLK) * 256 + h * 128 + R);
        const int e = T.blke[u.pm], idx = (u.pm - T.bstart[e]) * 256 + h * 128 + R;
        return idx < T.cnt[e] ? (unsigned)list[(size_t)e * LCAP + idx] : 0u;
    }
};
struct EpiSwiGLU {
    bf16* H;
    __device__ __forceinline__ void operator()(const f32x4 (&acc)[2][2][4][2], const pg8::Unit& u, int wr, int wc, int fr, int fq) const {
        const int row0 = u.pm * 256 + wr * 64 + fr, col0 = (u.pn & 3) * 128 + wc * 32 + 8 * fq;
#pragma unroll
        for (int ai = 0; ai < 2; ++ai)
#pragma unroll
            for (int m = 0; m < 4; ++m) { float h[8];
#pragma unroll
                for (int n = 0; n < 2; ++n)
#pragma unroll
                    for (int i = 0; i < 4; ++i) { const float g = acc[ai][0][m][n][i], up = acc[ai][1][m][n][i]; h[4 * n + i] = g * __builtin_amdgcn_rcpf(1.f + __expf(-g)) * up; }
                u32x4 w; w.x = cvt_pk_bf16(h[0], h[1]); w.y = cvt_pk_bf16(h[2], h[3]); w.z = cvt_pk_bf16(h[4], h[5]); w.w = cvt_pk_bf16(h[6], h[7]);
                *(u32x4*)(H + (size_t)(row0 + ai * 128 + m * 16) * FF + col0) = w; }
    }
};
struct EpiDown {
    bf16* Y;
    __device__ __forceinline__ void operator()(const f32x4 (&acc)[2][2][4][2], const pg8::Unit& u, int wr, int wc, int fr, int fq) const {
        const int row0 = u.pm * 256 + wr * 64 + fr, col0 = (u.pn & 7) * 256 + wc * 32 + 8 * fq;
#pragma unroll
        for (int ai = 0; ai < 2; ++ai)
#pragma unroll
            for (int m = 0; m < 4; ++m) { bf16* rowp = Y + (size_t)(row0 + ai * 128 + m * 16) * DM + col0;
#pragma unroll
                for (int bj = 0; bj < 2; ++bj) { const f32x4 v0 = acc[ai][bj][m][0], v1 = acc[ai][bj][m][1];
                    u32x4 w; w.x = cvt_pk_bf16(v0[0], v0[1]); w.y = cvt_pk_bf16(v0[2], v0[3]); w.z = cvt_pk_bf16(v1[0], v1[1]); w.w = cvt_pk_bf16(v1[2], v1[3]);
                    *(u32x4*)(rowp + bj * 128) = w; } }
    }
};

template <int L>
__device__ __forceinline__ void p_combine(const Ctx& C, const Args& a) {
    const float* mod = (const float*)(C.ws + WS_MOD) + (size_t)L * 5 * 12288; float* X = (float*)(C.ws + WS_X);
    const bf16* Y = (const bf16*)(C.ws + WS_Y); const int* INV = (const int*)(C.ws + WS_INV); const float* TW = (const float*)(C.ws + WS_TW);
    bf16* UM = (bf16*)(C.ws + WS_UM); const int* TE = (const int*)(C.ws + WS_TE);
    const MoeTab T = moe_tables<L>(C);
    const float* lng = a.in[I_LNG] + (size_t)(L * 2 + 1) * DM; const float* lnb = a.in[I_LNB] + (size_t)(L * 2 + 1) * DM;
    for (int r = C.gw; r < MROWS; r += C.ngw) {
        int b, p; row_info(r, b, p); const bool isctx = p < CL; if (L == 1 && isctx) continue;
        const float* mr = mod + (size_t)(isctx ? 4 : b) * 12288;
        int slot = 0; float wt = 0.f;
        if (C.lane < 6) { slot = T.bstart[TE[(size_t)r * 8 + C.lane]] * 256 + INV[(size_t)r * 8 + C.lane]; wt = TW[(size_t)r * 8 + C.lane]; }
        f32x4 f[8];
        { const bf16* ys = Y + ((size_t)XS_BLK * 256 + r) * DM;
#pragma unroll
          for (int j = 0; j < 8; ++j) { const u32x2 yw = *(const u32x2*)(ys + 4 * (C.lane + 64 * j)); f[j] = (f32x4){bf_lo(yw.x), bf_hi(yw.x), bf_lo(yw.y), bf_hi(yw.y)}; } }
#pragma unroll
        for (int k = 0; k < 6; ++k) { const int s = __shfl(slot, k); const float w = __shfl(wt, k); const bf16* ys = Y + (size_t)s * DM;
#pragma unroll
            for (int j = 0; j < 8; ++j) { const u32x2 yw = *(const u32x2*)(ys + 4 * (C.lane + 64 * j)); f[j] += (f32x4){bf_lo(yw.x), bf_hi(yw.x), bf_lo(yw.y), bf_hi(yw.y)} * w; } }
        float s = 0.f;
#pragma unroll
        for (int j = 0; j < 8; ++j) { const int e = 4 * (C.lane + 64 * j); f[j] = *(const f32x4*)(X + (size_t)r * DM + e) * DN_ALPHA + *(const f32x4*)(mr + 10240 + e) * f[j]; s += (f[j][0] + f[j][1]) + (f[j][2] + f[j][3]); }
        const float mean = wave_sum(s) * (1.f / DM); float s2 = 0.f;
#pragma unroll
        for (int j = 0; j < 8; ++j) { f[j] = f[j] - mean; s2 += (f[j][0] * f[j][0] + f[j][1] * f[j][1]) + (f[j][2] * f[j][2] + f[j][3] * f[j][3]); }
        const float rstd = 1.f / sqrtf(wave_sum(s2) * (1.f / DM) + LN_EPS);
        float* orow = (L == 0) ? X + (size_t)r * DM : a.out + ((size_t)(b * SEQ + (p - CL))) * DM;
        const float* mn = mod + (size_t)5 * 12288 + (size_t)(isctx ? 4 : b) * 12288;
#pragma unroll
        for (int j = 0; j < 8; ++j) { const int e = 4 * (C.lane + 64 * j); const f32x4 xn = f[j] * rstd * *(const f32x4*)(lng + e) + *(const f32x4*)(lnb + e);
            *(f32x4*)(orow + e) = xn;
            if (L == 0) { const f32x4 v = xn * (*(const f32x4*)(mn + 2048 + e) + 1.f) + *(const f32x4*)(mn + e);
                u32x2 w; w.x = cvt_pk_bf16(v[0], v[1]); w.y = cvt_pk_bf16(v[2], v[3]); *(u32x2*)(UM + (size_t)r * DM + e) = w; } }
    }
}

__device__ __forceinline__ void p13_mla_norm(const Ctx& C, const Args& a) {
    const bf16* dp = (const bf16*)(C.ws + WS_DOWNP); bf16* cq = (bf16*)(C.ws + WS_CQKV); bf16* ckv = cq + (size_t)MROWS * 512; bf16* kr = (bf16*)(C.ws + WS_KR);
    const f32x2* rope = (const f32x2*)(C.ws + WS_ROPE64);
    const f32x4 qga = *(const f32x4*)(a.in[I_MQG] + 8 * C.lane), qgb = *(const f32x4*)(a.in[I_MQG] + 8 * C.lane + 4);
    const f32x4 kga = *(const f32x4*)(a.in[I_MKVG] + 8 * C.lane), kgb = *(const f32x4*)(a.in[I_MKVG] + 8 * C.lane + 4);
    for (int r = C.gw; r < MROWS; r += C.ngw) {
        int b, p; row_info(r, b, p); const bool isctx = p < CL;
        const bf16* row = dp + (size_t)r * 1280;
#pragma unroll
        for (int part = 0; part < 2; ++part) {
            const u32x4 w = *(const u32x4*)(row + 512 * part + 8 * C.lane);
            float v[8] = {bf_lo(w.x), bf_hi(w.x), bf_lo(w.y), bf_hi(w.y), bf_lo(w.z), bf_hi(w.z), bf_lo(w.w), bf_hi(w.w)};
            float ss = 0.f;
#pragma unroll
            for (int q = 0; q < 8; ++q) ss += v[q] * v[q];
            const float rs = 1.f / sqrtf(wave_sum(ss) * (1.f / 512.f) + RMS_EPS);
            const f32x4 ga = part ? kga : qga, gb = part ? kgb : qgb;
            u32x4 o; o.x = cvt_pk_bf16(v[0] * rs * ga[0], v[1] * rs * ga[1]); o.y = cvt_pk_bf16(v[2] * rs * ga[2], v[3] * rs * ga[3]);
            o.z = cvt_pk_bf16(v[4] * rs * gb[0], v[5] * rs * gb[1]); o.w = cvt_pk_bf16(v[6] * rs * gb[2], v[7] * rs * gb[3]);
            *(u32x4*)((part ? ckv : cq) + (size_t)r * 512 + 8 * C.lane) = o;
        }
        if (C.lane < 32) { const float x1 = bf2f(row[1024 + C.lane]), x2 = bf2f(row[1056 + C.lane]);
            f32x2 cs = {1.f, 0.f}; if (!isctx) cs = rope[(size_t)(p - CL) * 32 + C.lane];
            kr[(size_t)r * 64 + C.lane] = (bf16)f2bf(x1 * cs.x - x2 * cs.y); kr[(size_t)r * 64 + 32 + C.lane] = (bf16)f2bf(x2 * cs.x + x1 * cs.y); }
    }
}

struct UpSched {
    int G, c;
    __device__ __forceinline__ bool next(int i, pg8::Unit& u) const {
        constexpr int NQ = 64 * 12, NKV = MT * 16; const long Lq = (long)i * G + c; if (Lq >= NQ + NKV) return false;
        const int w = pg8::xcd_remap((int)Lq, NQ + NKV); int pm, pn;
        if (w < NQ) { pg8::tile_of(w, 64, 12, pm, pn); pm = 17 * (pm >> 4) + 1 + (pm & 15); }
        else { pg8::tile_of(w - NQ, MT, 16, pm, pn); pm += MT; pn += 12; }
        u.pm = pm; u.pn = pn; return true;
    }
    __device__ __forceinline__ unsigned rowid(const pg8::Unit& u, int h, int R) const { return (unsigned)(u.pm * 256 + h * 128 + R); }
};
struct EpiUp {
    bf16* QB; bf16* KVB; const f32x2* rope;
    __device__ __forceinline__ void operator()(const f32x4 (&acc)[2][2][4][2], const pg8::Unit& u, int wr, int wc, int fr, int fq) const {
        const bool isq = u.pn < 12; const int rowt = isq ? u.pm : u.pm - MT;
        const int row0 = rowt * 256 + wr * 64 + fr, cw = wc * 32 + 8 * fq;
        bf16* base = isq ? QB + 256 * u.pn + cw : KVB + 256 * (u.pn - 12) + cw; const int ldc = isq ? 3072 : 4096;
        const bool dorope = isq && u.pn >= 8;
#pragma unroll
        for (int ai = 0; ai < 2; ++ai)
#pragma unroll
            for (int m = 0; m < 4; ++m) { const int row = row0 + ai * 128 + m * 16; bf16* rowp = base + (size_t)row * ldc;
                f32x4 a0 = acc[ai][0][m][0], a1 = acc[ai][0][m][1], b0 = acc[ai][1][m][0], b1 = acc[ai][1][m][1];
                if (dorope) { const int bb = row / RPB, pos = row - bb * RPB - CL; const f32x2* rp = rope + (size_t)pos * 32 + 8 * fq;
#pragma unroll
                    for (int i = 0; i < 4; ++i) { const f32x2 c0 = rp[i], c1 = rp[4 + i];
                        const float x1 = a0[i], x2 = b0[i]; a0[i] = x1 * c0.x - x2 * c0.y; b0[i] = x2 * c0.x + x1 * c0.y;
                        const float y1 = a1[i], y2 = b1[i]; a1[i] = y1 * c1.x - y2 * c1.y; b1[i] = y2 * c1.x + y1 * c1.y; } }
                u32x4 w; w.x = cvt_pk_bf16(a0[0], a0[1]); w.y = cvt_pk_bf16(a0[2], a0[3]); w.z = cvt_pk_bf16(a1[0], a1[1]); w.w = cvt_pk_bf16(a1[2], a1[3]);
                *(u32x4*)(rowp) = w;
                w.x = cvt_pk_bf16(b0[0], b0[1]); w.y = cvt_pk_bf16(b0[2], b0[3]); w.z = cvt_pk_bf16(b1[0], b1[1]); w.w = cvt_pk_bf16(b1[2], b1[3]);
                *(u32x4*)(rowp + 128) = w; }
    }
};

__device__ __forceinline__ void p15_attn1(const Ctx& C) {
    const bf16* qb = (const bf16*)(C.ws + WS_QB); const bf16* kvb = (const bf16*)(C.ws + WS_KVB); const bf16* kr = (const bf16*)(C.ws + WS_KR); bf16* attb = (bf16*)(C.ws + WS_ATT);
    const float scale = 0.07216878364870323f;
    for (int u = C.vcu; u < 1024; u += C.G) {
        const int bh = u >> 4, qblk = u & 15, b = bh >> 4, h = bh & 15, row0 = b * RPB + CL + 256 * qblk;
        const bf16* kn = kvb + (size_t)b * RPB * 4096 + 256 * h;
        att::attn_unit<1>(qb + (size_t)row0 * 3072 + 128 * h, qb + (size_t)row0 * 3072 + 2048 + 256 * (h >> 2) + 32 * (h & 3), 3072, kn, kn + 128, 4096, kr + (size_t)b * RPB * 64,
                          attb + (size_t)row0 * DM + 128 * h, DM, RPB, scale, (char*)C.lds);
    }
}

constexpr int NPH = 18;
__global__ void __launch_bounds__(512, 2) fwd(Args args) {
    extern __shared__ __attribute__((aligned(16))) unsigned char lds_raw[];
    Ctx C;
    C.lds = (LAS unsigned char*)lds_raw;
    C.tid = threadIdx.x; C.lane = C.tid & 63; C.wave = __builtin_amdgcn_readfirstlane(C.tid >> 6);
    C.G = gridDim.x; C.bid = blockIdx.x; C.vcu = (C.G % 8 == 0) ? (C.bid % 8) * (C.G / 8) + C.bid / 8 : C.bid;
    C.gw = C.bid * 8 + C.wave; C.ngw = C.G * 8;
    C.ws = args.ws; C.ctl = (unsigned*)(args.ws + WS_CTL);
    volatile LAS unsigned* MISC = (volatile LAS unsigned*)(C.lds + MISC_OFF);
    for (int u = C.tid; u < (LDS_BYTES - RING_BYTES) / 4; u += 512) ((LAS unsigned*)(C.lds + RING_BYTES))[u] = 0u;
    __syncthreads();
    XcdBarrier bar; bar.bar = C.ctl + CW_BAR; bar.x = 0; bar.st = nullptr;
    if (!MK_PER_PHASE) bar = xcd_barrier_post(C.ctl + CW_BAR, MISC + 8);
    const int lo = args.ph_lo, hi = args.ph_hi;
    unsigned char* ws = C.ws;
#ifndef PHMASK
#define PHMASK 0xFFFFFFFFu
#endif
#define IN(k) (((PHMASK >> (k)) & 1u) && lo <= (k) && (k) < hi)
#define SEAM(k) do { if (IN(k) && IN((k) + 1)) xcd_barrier(bar); } while (0)
#ifndef REP_MASK
#define REP_MASK 0u
#endif
#define REP2(k) ((((REP_MASK) >> (k)) & 1u) != 0u)
#define RUN(k, ...) do { if (IN(k)) { { __VA_ARGS__ } if (REP2(k)) { xcd_barrier(bar); { __VA_ARGS__ } } } } while (0)

    RUN(0, p0_prologue(C, args););
    SEAM(0);
    RUN(1, p1_modulate0(C, args););
    SEAM(1);
    RUN(2,        pg8::Gemm g{(const bf16*)(ws + WS_UM), (const bf16*)(ws + WS_W_IN), DM}; DenseSched S{MT, A_IN / 256, C.G, C.bid, 0, 0, 0};
        EpiStoreBf16 E{(bf16*)(ws + WS_PROJ), A_IN}; pg8::gemm_phase(C.lds, g, S, E);
    );
    SEAM(2);
    if (IN(3)) p3_qk_conv(C, args);
    SEAM(3);
    RUN(4, p4_attn0(C););
    SEAM(4);
    RUN(5,        pg8::Gemm g{(const bf16*)(ws + WS_MIX), (const bf16*)(ws + WS_W_OUT0), DM}; DenseSched S{MT, DM / 256, C.G, C.bid, 0, 0, 0};
        EpiStoreBf16 E{(bf16*)(ws + WS_Y1_0), DM}; pg8::gemm_phase(C.lds, g, S, E);
    );
    SEAM(5);
    if (IN(6)) p_ln_route<0>(C, args);
    SEAM(6);
    RUN(7,
        const MoeTab T = moe_tables<0>(C);
        pg8::Gemm g{(const bf16*)(ws + WS_U), (const bf16*)(ws + WS_W_GU), DM};
        MoeSched S{T, (const int*)(ws + WS_LIST), T.bstart[NE], SH_BLK, 4, C.G, C.bid, 0, 1};
        EpiSwiGLU E{(bf16*)(ws + WS_H)}; pg8::gemm_phase(C.lds, g, S, E);
    );
    SEAM(7);
    RUN(8,
        const MoeTab T = moe_tables<0>(C);
        pg8::Gemm g{(const bf16*)(ws + WS_H), (const bf16*)(ws + WS_W_D), FF};
        MoeSched S{T, nullptr, T.bstart[NE], SH_BLK, 8, C.G, C.bid, 0, 0};
        EpiDown E{(bf16*)(ws + WS_Y)}; pg8::gemm_phase(C.lds, g, S, E);
    );
    SEAM(8);
    if (IN(9)) p_combine<0>(C, args);
    SEAM(9);
    RUN(10,
        pg8::Gemm g{(const bf16*)(ws + WS_UM), (const bf16*)(ws + WS_W_DOWN), DM}; DenseSched S{MT, 5, C.G, C.bid, 0, 0, 0};
        EpiStoreBf16 E{(bf16*)(ws + WS_DOWNP), 1280}; pg8::gemm_phase(C.lds, g, S, E);
    );
    SEAM(10);
    RUN(11, p13_mla_norm(C, args););
    SEAM(11);
    RUN(12,
        pg8::Gemm g{(const bf16*)(ws + WS_CQKV), (const bf16*)(ws + WS_W_UQKV), 512}; UpSched S{C.G, C.bid};
        EpiUp E{(bf16*)(ws + WS_QB), (bf16*)(ws + WS_KVB), (const f32x2*)(ws + WS_ROPE64)}; pg8::gemm_phase(C.lds, g, S, E);
    );
    SEAM(12);
    RUN(13, p15_attn1(C););
    SEAM(13);
    RUN(14,
        pg8::Gemm g{(const bf16*)(ws + WS_ATT), (const bf16*)(ws + WS_W_OUT1), DM}; DenseSched S{64, DM / 256, C.G, C.bid, 1, 0, 0};
        EpiStoreBf16 E{(bf16*)(ws + WS_Y1_1), DM}; pg8::gemm_phase(C.lds, g, S, E);
    );
    SEAM(14);
    if (IN(15)) p_ln_route<1>(C, args);
    SEAM(15);
    RUN(16,
        const MoeTab T = moe_tables<1>(C);
        pg8::Gemm g{(const bf16*)(ws + WS_U), (const bf16*)(ws + WS_W_GU) + W_GU_L, DM};
        MoeSched S{T, (const int*)(ws + WS_LIST), T.bstart[NE], 64, 4, C.G, C.bid, 1, 1};
        EpiSwiGLU E{(bf16*)(ws + WS_H)}; pg8::gemm_phase(C.lds, g, S, E);
    );
    SEAM(16);
    RUN(17,
        const MoeTab T = moe_tables<1>(C);
        pg8::Gemm g{(const bf16*)(ws + WS_H), (const bf16*)(ws + WS_W_D) + W_D_L, FF};
        MoeSched S{T, nullptr, T.bstart[NE], 64, 8, C.G, C.bid, 1, 0};
        EpiDown E{(bf16*)(ws + WS_Y)}; pg8::gemm_phase(C.lds, g, S, E);
    );
    SEAM(17);
    if (IN(18)) p_combine<1>(C, args);
#undef IN
#undef SEAM
}

extern "C" void kernel_launch(void* const* d_in, const int* in_sizes, int n_in, void* d_out, int out_size, void* d_ws, size_t ws_size, hipStream_t stream) {
    static int grid = 0;
    if (grid == 0) {
        if (n_in != 27 || ws_size < WS_END) { fprintf(stderr, "kernel_launch: n_in %d ws %zu (need %zu)\n", n_in, ws_size, (size_t)WS_END); grid = -1; return; }
        int dev = 0, cus = 0, per_cu = 0;
        if (hipGetDevice(&dev) != hipSuccess || hipDeviceGetAttribute(&cus, hipDeviceAttributeMultiprocessorCount, dev) != hipSuccess) { grid = -1; return; }
        if (hipFuncSetAttribute((const void*)fwd, hipFuncAttributeMaxDynamicSharedMemorySize, LDS_BYTES) != hipSuccess) { fprintf(stderr, "kernel_launch: hipFuncSetAttribute failed\n"); grid = -1; return; }
        if (hipOccupancyMaxActiveBlocksPerMultiprocessor(&per_cu, (const void*)fwd, 512, LDS_BYTES) != hipSuccess || per_cu < 1) fprintf(stderr, "kernel_launch: occupancy query says %d\n", per_cu);
        (void)hipGetLastError();
        grid = cus;
    }
    if (grid < 0) return;
    if (hipMemsetAsync((char*)d_ws + WS_CTL, 0, CTL_ZERO_BYTES, stream) != hipSuccess) return;
    Args a{};
    for (int i = 0; i < 27; ++i) a.in[i] = (const float*)d_in[i];
    a.out = (float*)d_out; a.ws = (unsigned char*)d_ws;
#if MK_PER_PHASE
    for (int k = 0; k <= NPH; ++k) { a.ph_lo = k; a.ph_hi = k + 1; hipLaunchKernelGGL(fwd, dim3(grid), dim3(512), LDS_BYTES, stream, a); }
#else
    a.ph_lo = 0; a.ph_hi = NPH + 1;
    hipLaunchKernelGGL(fwd, dim3(grid), dim3(512), LDS_BYTES, stream, a);
#endif
    const hipError_t le = hipPeekAtLastError();
    if (le != hipSuccess) fprintf(stderr, "kernel_launch: launch failed: %s\n", hipGetErrorName(le));
}
```
